# Optimizing an MI355X kernel written in HIP

```python
import math
import jax, jax.numpy as jnp
from jax import lax
import numpy as np

D_MODEL = 1024
BATCH = 4
SEQ = 4096
DEPTH = 2

CHUNK = 64
MEM_LEN = 256
Q_BLOCK = 128
RMS_EPS = 1e-6
NEG_INF = -1e30

FOX_HEAD_DIM = 64
FOX_HEADS = (D_MODEL // 2) // FOX_HEAD_DIM
DIFF_QK_DIM = 64
DIFF_V_DIM = 2 * DIFF_QK_DIM
DIFF_HEADS = (D_MODEL // 2) // DIFF_V_DIM
ATTN_IN_WIDTH = 3 * FOX_HEADS * FOX_HEAD_DIM + FOX_HEADS + DIFF_HEADS * (4 * DIFF_QK_DIM + DIFF_V_DIM)
MLSTM_HEADS = 4
MLSTM_V_DIM = D_MODEL // MLSTM_HEADS
MLSTM_QK_DIM = MLSTM_V_DIM // 2
MLSTM_CONV = 4
MLSTM_IN_WIDTH = 2 * MLSTM_HEADS * MLSTM_QK_DIM + 2 * MLSTM_HEADS * MLSTM_V_DIM + 2 * MLSTM_HEADS
XATTN_HEADS = 4
XATTN_HEAD_DIM = D_MODEL // XATTN_HEADS
D_FF = 256 * math.ceil(8 * D_MODEL / 3 / 256)
FFN_CONV = 3
N_EVEN = (DEPTH + 1) // 2
N_ODD = DEPTH // 2

kernel_name = "fox_diff_mlstm_convffn_hybrid"


def rms_norm(x, gain):
    x32 = x.astype(jnp.float32)
    y = x32 * lax.rsqrt(jnp.mean(x32 * x32, axis=-1, keepdims=True) + RMS_EPS)
    return (y * gain.astype(jnp.float32)).astype(x.dtype)


def causal_depthwise_conv(x, w):
    K = w.shape[0]
    S = x.shape[1]
    xp = jnp.pad(x, ((0, 0), (K - 1, 0), (0, 0)))
    y = xp[:, 0:S, :] * w[0]
    for tap in range(1, K):
        y = y + xp[:, tap:tap + S, :] * w[tap]
    return y


def split_heads(t, n_heads):
    B, S, _ = t.shape
    return t.reshape(B, S, n_heads, -1).transpose(0, 2, 1, 3)


def merge_heads(t):
    B, H, S, d = t.shape
    return t.transpose(0, 2, 1, 3).reshape(B, S, H * d)


def to_blocks(t, size):
    B, H, S = t.shape[:3]
    return jnp.moveaxis(t.reshape(B, H, S // size, size, *t.shape[3:]), 2, 0)


def from_blocks(t):
    nb, B, H, size = t.shape[:4]
    return jnp.moveaxis(t, 0, 2).reshape(B, H, nb * size, *t.shape[4:])


def forgetting_attention(q, k, v, log_f):
    S = q.shape[2]
    scale = q.shape[-1] ** -0.5
    F = jnp.cumsum(log_f, axis=-1)
    k_pos = jnp.arange(S)
    starts = jnp.arange(S // Q_BLOCK) * Q_BLOCK

    def block(args):
        start, q_b, F_b = args
        q_pos = start + jnp.arange(Q_BLOCK)
        logits = jnp.einsum('bhqd,bhkd->bhqk', q_b, k, preferred_element_type=jnp.float32) * scale
        logits = logits + F_b[..., :, None] - F[..., None, :]
        logits = jnp.where(k_pos[None, :] <= q_pos[:, None], logits, NEG_INF)
        p = jax.nn.softmax(logits, axis=-1)
        return jnp.einsum('bhqk,bhkd->bhqd', p.astype(v.dtype), v)

    out = lax.map(block, (starts, to_blocks(q, Q_BLOCK), to_blocks(F, Q_BLOCK)))
    return from_blocks(out)


def differential_attention(q1, q2, k1, k2, v, lam):
    S = q1.shape[2]
    scale = q1.shape[-1] ** -0.5
    k_chunk = jnp.arange(S) // CHUNK
    starts = jnp.arange(S // Q_BLOCK) * Q_BLOCK

    def block(args):
        start, q1_b, q2_b = args
        q_chunk = (start + jnp.arange(Q_BLOCK)) // CHUNK
        mask = k_chunk[None, :] <= q_chunk[:, None]
        l1 = jnp.einsum('bhqd,bhkd->bhqk', q1_b, k1, preferred_element_type=jnp.float32) * scale
        l2 = jnp.einsum('bhqd,bhkd->bhqk', q2_b, k2, preferred_element_type=jnp.float32) * scale
        p1 = jax.nn.softmax(jnp.where(mask, l1, NEG_INF), axis=-1)
        p2 = jax.nn.softmax(jnp.where(mask, l2, NEG_INF), axis=-1)
        p = p1 - lam * p2
        return jnp.einsum('bhqk,bhkd->bhqd', p.astype(v.dtype), v)

    out = lax.map(block, (starts, to_blocks(q1, Q_BLOCK), to_blocks(q2, Q_BLOCK)))
    return from_blocks(out)


def fox_diff_mixer(xn, w_in, fox_bf, lq1, lk1, lq2, lk2, subln, w_out, lambda_init):
    B, S, _ = xn.shape
    proj = xn @ w_in
    fw = FOX_HEADS * FOX_HEAD_DIM
    dqk = DIFF_HEADS * 2 * DIFF_QK_DIM
    cuts = np.cumsum([fw, fw, fw, FOX_HEADS, dqk, dqk]).tolist()
    fq, fk, fv, ff, dq, dk, dv = jnp.split(proj, cuts, axis=-1)
    log_f = jax.nn.log_sigmoid((ff + fox_bf).astype(jnp.float32)).transpose(0, 2, 1)
    fox_out = forgetting_attention(split_heads(fq, FOX_HEADS), split_heads(fk, FOX_HEADS),
                                   split_heads(fv, FOX_HEADS), log_f)
    dq = dq.reshape(B, S, DIFF_HEADS, 2, DIFF_QK_DIM).transpose(0, 2, 3, 1, 4)
    dk = dk.reshape(B, S, DIFF_HEADS, 2, DIFF_QK_DIM).transpose(0, 2, 3, 1, 4)
    lam = (jnp.exp(jnp.sum(lq1.astype(jnp.float32) * lk1.astype(jnp.float32)))
           - jnp.exp(jnp.sum(lq2.astype(jnp.float32) * lk2.astype(jnp.float32))) + lambda_init)
    d_out = differential_attention(dq[:, :, 0], dq[:, :, 1], dk[:, :, 0], dk[:, :, 1],
                                   split_heads(dv, DIFF_HEADS), lam)
    d_out = rms_norm(d_out, subln) * (1.0 - lambda_init)
    mixed = jnp.concatenate([merge_heads(fox_out), merge_heads(d_out)], axis=-1)
    return mixed @ w_out


def mlstm_chunkwise(q, k, v, i_pre, log_f):
    B, H, _, dqk = q.shape
    dv = v.shape[-1]
    causal = jnp.tril(jnp.ones((CHUNK, CHUNK), dtype=bool))

    def step(carry, xs):
        C, n, m = carry
        qc, kc, vc, ic, fc = xs
        b = jnp.cumsum(fc, axis=-1)
        g = b[..., -1]
        D = jnp.where(causal, b[..., :, None] - b[..., None, :] + ic[..., None, :], NEG_INF)
        inter = b + m[..., None]
        m_t = jnp.maximum(inter, jnp.max(D, axis=-1))
        w_inter = jnp.exp(inter - m_t)
        W = jnp.exp(D - m_t[..., None])
        qk = jnp.einsum('bhtd,bhsd->bhts', qc, kc) * W
        num = w_inter[..., None] * jnp.einsum('bhtd,bhde->bhte', qc, C) + jnp.einsum('bhts,bhse->bhte', qk, vc)
        den = w_inter * jnp.einsum('bhtd,bhd->bht', qc, n) + jnp.sum(qk, axis=-1)
        h = num / jnp.maximum(jnp.abs(den), jnp.exp(-m_t))[..., None]
        a = g[..., None] - b + ic
        m_new = jnp.maximum(g + m, jnp.max(a, axis=-1))
        decay = jnp.exp(g + m - m_new)
        wk = jnp.exp(a - m_new[..., None])
        C_new = decay[..., None, None] * C + jnp.einsum('bhs,bhsd,bhse->bhde', wk, kc, vc)
        n_new = decay[..., None] * n + jnp.einsum('bhs,bhsd->bhd', wk, kc)
        return (C_new, n_new, m_new), h

    init = (jnp.zeros((B, H, dqk, dv), jnp.float32), jnp.zeros((B, H, dqk), jnp.float32),
            jnp.zeros((B, H), jnp.float32))
    xs = (to_blocks(q, CHUNK), to_blocks(k, CHUNK), to_blocks(v, CHUNK),
          to_blocks(i_pre, CHUNK), to_blocks(log_f, CHUNK))
    _, h = lax.scan(step, init, xs)
    return from_blocks(h)


def mlstm_mixer(xn, w_in, conv_qk, b_i, b_f, head_norm, w_out):
    proj = xn @ w_in
    qkw = MLSTM_HEADS * MLSTM_QK_DIM
    vw = MLSTM_HEADS * MLSTM_V_DIM
    cuts = np.cumsum([2 * qkw, vw, MLSTM_HEADS, MLSTM_HEADS]).tolist()
    qk_pre, v, ig, fg, og = jnp.split(proj, cuts, axis=-1)
    qk = jax.nn.silu(causal_depthwise_conv(qk_pre, conv_qk))
    q, k = jnp.split(qk, 2, axis=-1)
    q = split_heads(q, MLSTM_HEADS).astype(jnp.float32) * (MLSTM_QK_DIM ** -0.5)
    k = split_heads(k, MLSTM_HEADS).astype(jnp.float32)
    v = split_heads(v, MLSTM_HEADS).astype(jnp.float32)
    i_pre = (ig + b_i).astype(jnp.float32).transpose(0, 2, 1)
    log_f = jax.nn.log_sigmoid((fg + b_f).astype(jnp.float32)).transpose(0, 2, 1)
    h = mlstm_chunkwise(q, k, v, i_pre, log_f)
    h = rms_norm(h, head_norm.reshape(MLSTM_HEADS, 1, MLSTM_V_DIM))
    h = merge_heads(h).astype(xn.dtype) * jax.nn.sigmoid(og)
    return h @ w_out


def memory_cross_attention(xn, memn, wq, wkv, wo):
    q = split_heads(xn @ wq, XATTN_HEADS)
    k, v = jnp.split(memn @ wkv, 2, axis=-1)
    k = split_heads(k, XATTN_HEADS)
    v = split_heads(v, XATTN_HEADS)
    logits = jnp.einsum('bhqd,bhmd->bhqm', q, k, preferred_element_type=jnp.float32) * (XATTN_HEAD_DIM ** -0.5)
    p = jax.nn.softmax(logits, axis=-1)
    out = jnp.einsum('bhqm,bhmd->bhqd', p.astype(v.dtype), v)
    return merge_heads(out) @ wo


def conv_ffn(xn, w_up, conv_w, conv_b, w_down):
    h = causal_depthwise_conv(xn @ w_up, conv_w) + conv_b
    g, u = jnp.split(h, 2, axis=-1)
    return (jax.nn.gelu(g) * u) @ w_down


def setup_inputs(seed: int = 0) -> dict:
    key = jax.random.key(seed)
    ks = iter(jax.random.split(key, 40))

    def nrm(shape, scale):
        return jax.random.normal(next(ks), shape, jnp.float32) * scale

    def gain(shape):
        return 1.0 + nrm(shape, 0.02)

    out_scale = (2.0 * D_MODEL) ** -0.5
    return {
        'x': nrm((BATCH, SEQ, D_MODEL), 1.0),
        'mem': nrm((BATCH, MEM_LEN, D_MODEL), 1.0),
        'mix_norm': gain((DEPTH, D_MODEL)),
        'xattn_norm': gain((DEPTH, D_MODEL)),
        'mem_norm': gain((DEPTH, D_MODEL)),
        'ffn_norm': gain((DEPTH, D_MODEL)),
        'attn_w_in': nrm((N_EVEN, D_MODEL, ATTN_IN_WIDTH), D_MODEL ** -0.5),
        'attn_fox_bf': jnp.linspace(1.0, 4.0, FOX_HEADS, dtype=jnp.float32) + nrm((N_EVEN, FOX_HEADS), 0.1),
        'diff_lq1': nrm((N_EVEN, DIFF_QK_DIM), 0.1),
        'diff_lk1': nrm((N_EVEN, DIFF_QK_DIM), 0.1),
        'diff_lq2': nrm((N_EVEN, DIFF_QK_DIM), 0.1),
        'diff_lk2': nrm((N_EVEN, DIFF_QK_DIM), 0.1),
        'diff_subln': gain((N_EVEN, DIFF_V_DIM)),
        'attn_w_out': nrm((N_EVEN, D_MODEL, D_MODEL), out_scale),
        'mlstm_w_in': nrm((N_ODD, D_MODEL, MLSTM_IN_WIDTH), D_MODEL ** -0.5),
        'mlstm_conv_qk': nrm((N_ODD, MLSTM_CONV, 2 * MLSTM_HEADS * MLSTM_QK_DIM), MLSTM_CONV ** -0.5),
        'mlstm_b_i': nrm((N_ODD, MLSTM_HEADS), 0.1),
        'mlstm_b_f': jnp.linspace(3.0, 6.0, MLSTM_HEADS, dtype=jnp.float32) + nrm((N_ODD, MLSTM_HEADS), 0.1),
        'mlstm_head_norm': gain((N_ODD, MLSTM_HEADS * MLSTM_V_DIM)),
        'mlstm_w_out': nrm((N_ODD, D_MODEL, D_MODEL), out_scale),
        'xattn_wq': nrm((DEPTH, D_MODEL, D_MODEL), D_MODEL ** -0.5),
        'xattn_wkv': nrm((DEPTH, D_MODEL, 2 * D_MODEL), D_MODEL ** -0.5),
        'xattn_wo': nrm((DEPTH, D_MODEL, D_MODEL), out_scale),
        'ffn_w_up': nrm((DEPTH, D_MODEL, 2 * D_FF), D_MODEL ** -0.5),
        'ffn_conv_w': nrm((DEPTH, FFN_CONV, 2 * D_FF), FFN_CONV ** -0.5),
        'ffn_conv_b': nrm((DEPTH, 2 * D_FF), 0.02),
        'ffn_w_down': nrm((DEPTH, D_FF, D_MODEL), (2.0 * D_FF) ** -0.5),
        'final_norm': gain((D_MODEL,)),
    }


def reference(x, mem, mix_norm, xattn_norm, mem_norm, ffn_norm,
              attn_w_in, attn_fox_bf, diff_lq1, diff_lk1, diff_lq2, diff_lk2, diff_subln, attn_w_out,
              mlstm_w_in, mlstm_conv_qk, mlstm_b_i, mlstm_b_f, mlstm_head_norm, mlstm_w_out,
              xattn_wq, xattn_wkv, xattn_wo,
              ffn_w_up, ffn_conv_w, ffn_conv_b, ffn_w_down, final_norm):
    for layer in range(DEPTH):
        j = layer // 2
        xn = rms_norm(x, mix_norm[layer])
        if layer % 2 == 0:
            lambda_init = 0.8 - 0.6 * math.exp(-0.3 * layer)
            mixed = fox_diff_mixer(xn, attn_w_in[j], attn_fox_bf[j], diff_lq1[j], diff_lk1[j],
                                   diff_lq2[j], diff_lk2[j], diff_subln[j], attn_w_out[j], lambda_init)
        else:
            mixed = mlstm_mixer(xn, mlstm_w_in[j], mlstm_conv_qk[j], mlstm_b_i[j], mlstm_b_f[j],
                                mlstm_head_norm[j], mlstm_w_out[j])
        x = x + mixed
        x = x + memory_cross_attention(rms_norm(x, xattn_norm[layer]), rms_norm(mem, mem_norm[layer]),
                                       xattn_wq[layer], xattn_wkv[layer], xattn_wo[layer])
        x = x + conv_ffn(rms_norm(x, ffn_norm[layer]), ffn_w_up[layer], ffn_conv_w[layer],
                         ffn_conv_b[layer], ffn_w_down[layer])
    return rms_norm(x, final_norm)
```

```cpp
#include <hip/hip_runtime.h>
#include <hip/hip_cooperative_groups.h>
#include <cstdio>
#include <cstdint>
#include <cmath>
namespace cg = cooperative_groups;

namespace pg8 {
#define PG8_LAS __attribute__((address_space(3)))
typedef unsigned short bf16_t;
typedef short bf16x8 __attribute__((ext_vector_type(8)));
typedef float f32x4 __attribute__((ext_vector_type(4)));
typedef unsigned u32x4 __attribute__((ext_vector_type(4)));
constexpr int BM = 256, BK = 64, HALF = 128, HTB = HALF * BK * 2  , STAGE_BYTES = 8 * HTB, NXCD = 8, WGM = 8;

__host__ __device__ __forceinline__ int lds_byte(int r, int c) { const int st = (r >> 4) * 2 + (c >> 5), rr = r & 15, cc = c & 31, ob = rr * 64 + cc * 2; return st * 1024 + (ob ^ (((ob >> 9) & 1) << 5)); }
__host__ __device__ __forceinline__ void stage_rc(int b, int& R, int& C) { const int st = b / 1024, sb = b % 1024, swz = sb ^ (((sb >> 9) & 1) << 5); R = (st >> 1) * 16 + swz / 64; C = (st & 1) * 32 + (swz % 64) / 2; }
__host__ __device__ __forceinline__ int perm32(int rho) { const int n = rho >> 4, i = rho & 15; return 8 * (i >> 2) + 4 * n + (i & 3); }

struct Unit { int pm, pn; };
struct Gemm { const bf16_t* A; const bf16_t* Bt; int M, N, K; };

struct StaticOrder {
    int nM, nN, nwg, G, c;
    __host__ __device__ void init(int M, int N, int G_, int c_) { nM = M / BM; nN = N / BM; nwg = nM * nN; G = G_; c = c_; }
    __host__ __device__ bool next(int i, Unit& u) const {
        const long L = (long)i * G + c; if (L >= nwg) return false;
        int wgid = (int)L; { const int q = nwg / NXCD, r = nwg % NXCD, xcd = wgid % NXCD, off = wgid / NXCD; wgid = (xcd < r ? xcd * (q + 1) : r * (q + 1) + (xcd - r) * q) + off; }
        const int nig = WGM * nN, gid = wgid / nig, fm = gid * WGM, gsz = (nM - fm) < WGM ? (nM - fm) : WGM;
        u.pm = fm + ((wgid % nig) % gsz); u.pn = (wgid % nig) / gsz; return true;
    }
    __device__ __forceinline__ void a_ready(const Unit&) const {}
    __device__ __forceinline__ void done(const Unit&) const {}
};

__device__ __forceinline__ unsigned cvt_pk_bf16(float lo, float hi) { unsigned r; asm volatile("v_cvt_pk_bf16_f32 %0, %1, %2" : "=v"(r) : "v"(lo), "v"(hi)); return r; }
typedef float f32x2 __attribute__((ext_vector_type(2)));
__device__ __forceinline__ f32x2 gelu_pk(f32x2 v) {
    const f32x2 av = __builtin_elementwise_abs(v), d = av * 0.2316418882f + 1.0f;
    f32x2 t; t.x = __builtin_amdgcn_rcpf(d.x); t.y = __builtin_amdgcn_rcpf(d.y);
    f32x2 q = t * 0.5307027145f + (-0.7265760135f); q = q * t + 0.7107068705f; q = q * t + (-0.142248368f); q = q * t + 0.127414796f; q = q * t;
    const f32x2 s = (v * v) * (-0.72134752044f);
    f32x2 e; e.x = __builtin_amdgcn_exp2f(s.x); e.y = __builtin_amdgcn_exp2f(s.y);
    const f32x2 m = v * (q * e), r = v - m;
    f32x2 o; o.x = v.x < 0.f ? m.x : r.x; o.y = v.y < 0.f ? m.y : r.y; return o;
}

template <int ACT  > struct EpiBf16 {
    static constexpr bool PERM = true, AFTER_DRAIN = false; static_assert(ACT == 0 || ACT == 1, "EpiBf16: ACT is 0 (none) or 1 (gelu_pk)");
    bf16_t* O; int ldc; const float* bias; int split_cols; size_t split_stride; float scale0;
    __device__ __forceinline__ void operator()(const f32x4 (&acc)[2][2][4][2], const Unit& u, int wr, int wc, int fr, int fq) const {
        const int row0 = u.pm * BM + wr * 64 + fr; int colt = u.pn * BM; bf16_t* base = O;
        float sc = 1.f; if (split_cols) { const int t = colt / split_cols; base += (size_t)t * split_stride; colt -= t * split_cols; if (t == 0) sc = scale0; }
        const int col0 = colt + wc * 32 + 8 * fq, bcol0 = u.pn * BM + wc * 32 + 8 * fq;
        f32x4 bv[2][2];
#pragma unroll
        for (int bj = 0; bj < 2; ++bj)
#pragma unroll
            for (int n = 0; n < 2; ++n) bv[bj][n] = bias ? *(const f32x4*)(bias + bcol0 + bj * HALF + 4 * n) : (f32x4){0.f, 0.f, 0.f, 0.f};
#pragma unroll
        for (int ai = 0; ai < 2; ++ai)
#pragma unroll
            for (int m = 0; m < 4; ++m) { bf16_t* rowp = base + (size_t)(row0 + ai * HALF + m * 16) * ldc + col0;
#pragma unroll
                for (int bj = 0; bj < 2; ++bj) { f32x4 v0 = acc[ai][bj][m][0] + bv[bj][0], v1 = acc[ai][bj][m][1] + bv[bj][1];
                    if (ACT == 1) { f32x2 a = gelu_pk((f32x2){v0[0], v0[1]}), b = gelu_pk((f32x2){v0[2], v0[3]}), c = gelu_pk((f32x2){v1[0], v1[1]}), d = gelu_pk((f32x2){v1[2], v1[3]});
                        v0 = (f32x4){a.x, a.y, b.x, b.y}; v1 = (f32x4){c.x, c.y, d.x, d.y}; }
                    v0 = v0 * sc; v1 = v1 * sc; u32x4 w; w.x = cvt_pk_bf16(v0[0], v0[1]); w.y = cvt_pk_bf16(v0[2], v0[3]); w.z = cvt_pk_bf16(v1[0], v1[1]); w.w = cvt_pk_bf16(v1[2], v1[3]);
                    *(u32x4*)(rowp + bj * HALF) = w; } }
    }
};
template <class Epi> constexpr auto epi_aperm(int) -> decltype(Epi::APERM) { return Epi::APERM; }
template <class Epi> constexpr bool epi_aperm(long) { return false; }
template <class Epi, class Sched, bool ALIGN_EPI = false, bool SP2 = false>
__device__ __forceinline__ void gemm_phase(PG8_LAS unsigned char* lds, const Gemm g, const Sched& S, const Epi& E) {
    int tid_ = threadIdx.x; asm volatile("" : "+v"(tid_));
    const int tid = tid_, wid = __builtin_amdgcn_readfirstlane(tid >> 6), lane = tid & 63, wr = wid >> 2, wc = wid & 3, fr = lane & 15, fq = lane >> 4;
    const int K = g.K, nt = K / BK;
    unsigned voffA[2], voffB[2];
#pragma unroll
    for (int i = 0; i < 2; ++i) { int R, C; stage_rc(tid * 16 + i * 8192, R, C); const int Rb = Epi::PERM ? ((R & ~31) + perm32(R & 31)) : R;
        const int Ra = epi_aperm<Epi>(0) ? ((R & ~63) + 4 * (R & 15) + ((R >> 4) & 3)) : R;
        voffA[i] = (unsigned)(Ra * K + C) * 2u; voffB[i] = (unsigned)(Rb * K + C) * 2u; }
    const size_t kstep = (size_t)(BK * 2);
    const size_t hstep = (size_t)HALF * K * 2;
    const size_t tstep = 2 * hstep;
    const unsigned ldsw = (unsigned)wid * 1024u;
    const int aoff = lds_byte(wr * 64 + fr, fq * 8), boff = lds_byte(wc * 32 + fr, fq * 8);
#define PG8_SA(b, h) (((b) * 2 + (h)) * HTB)
#define PG8_SB(b, h) ((4 + (b) * 2 + (h)) * HTB)
#define PG8_STAGE(bufoff, gbase, voff) do { _Pragma("unroll") for (int _i = 0; _i < 2; ++_i) \
        __builtin_amdgcn_global_load_lds((const unsigned*)((const char*)(gbase) + (voff)[_i]), (PG8_LAS unsigned*)(lds + (bufoff) + ldsw + _i * 8192), 16, 0, 0); } while (0)
#define PG8_LDA(dst, b, h) do { _Pragma("unroll") for (int m = 0; m < 4; ++m) _Pragma("unroll") for (int k = 0; k < 2; ++k) dst[m][k] = *(const PG8_LAS bf16x8*)(lds + PG8_SA(b, h) + aoff + m * 2048 + k * 1024); } while (0)
#define PG8_LDB(dst, b, h) do { _Pragma("unroll") for (int n = 0; n < 2; ++n) _Pragma("unroll") for (int k = 0; k < 2; ++k) dst[n][k] = *(const PG8_LAS bf16x8*)(lds + PG8_SB(b, h) + boff + n * 2048 + k * 1024); } while (0)
#define PG8_MMA(ai, bj, At, Bt) do { __builtin_amdgcn_s_setprio(1); _Pragma("unroll") for (int m = 0; m < 4; ++m) _Pragma("unroll") for (int n = 0; n < 2; ++n) _Pragma("unroll") for (int k = 0; k < 2; ++k) \
        acc[ai][bj][m][n] = __builtin_amdgcn_mfma_f32_16x16x32_bf16(Bt[n][k], At[m][k], acc[ai][bj][m][n], 0, 0, 0); __builtin_amdgcn_s_setprio(0); } while (0)
#define PG8_WAIT_V(n) asm volatile("s_waitcnt vmcnt(" #n ")" ::: "memory")
#define PG8_WAIT_L(n) asm volatile("s_waitcnt lgkmcnt(" #n ")" ::: "memory")
#define PG8_BAR __builtin_amdgcn_s_barrier()
#define PG8_SCHED __builtin_amdgcn_sched_barrier(0)
    Unit cur, nxt; int ui = 0;
    if (!S.next(0, cur)) return;
    f32x4 acc[2][2][4][2];
#pragma unroll
    for (int a = 0; a < 2; ++a)
#pragma unroll
        for (int b = 0; b < 2; ++b)
#pragma unroll
            for (int m = 0; m < 4; ++m)
#pragma unroll
                for (int n = 0; n < 2; ++n) acc[a][b][m][n] = (f32x4){0.f, 0.f, 0.f, 0.f};
    bf16x8 At[4][2], B0[2][2], B1[2][2];
    const char* cA = (const char*)g.A + (size_t)cur.pm * tstep; const char* cB = (const char*)g.Bt + (size_t)cur.pn * tstep;
    S.a_ready(cur);
    if constexpr (SP2) {
        PG8_STAGE(PG8_SB(0, 0), cB, voffB); PG8_STAGE(PG8_SB(0, 1), cB + hstep, voffB); PG8_STAGE(PG8_SA(0, 0), cA, voffA); PG8_STAGE(PG8_SA(0, 1), cA + hstep, voffA);
        if (wr == 1) PG8_BAR;
        PG8_WAIT_V(2); PG8_BAR;
        PG8_STAGE(PG8_SB(1, 0), cB + kstep, voffB); PG8_STAGE(PG8_SA(1, 0), cA + kstep, voffA); PG8_STAGE(PG8_SB(1, 1), cB + hstep + kstep, voffB);
        PG8_WAIT_V(6); PG8_BAR;
    } else {
        PG8_STAGE(PG8_SB(0, 0), cB, voffB); PG8_STAGE(PG8_SA(0, 0), cA, voffA); PG8_STAGE(PG8_SB(0, 1), cB + hstep, voffB); PG8_STAGE(PG8_SA(0, 1), cA + hstep, voffA);
        if (wr == 1) PG8_BAR;
        PG8_WAIT_V(4); PG8_BAR;
        PG8_STAGE(PG8_SB(1, 0), cB + kstep, voffB); PG8_STAGE(PG8_SA(1, 0), cA + kstep, voffA); PG8_STAGE(PG8_SB(1, 1), cB + hstep + kstep, voffB);
        PG8_WAIT_V(6); PG8_BAR;
    }
    for (;;) {
        const bool has_next = S.next(ui + 1, nxt);
        const char* nA = has_next ? (const char*)g.A + (size_t)nxt.pm * tstep : cA; const char* nB = has_next ? (const char*)g.Bt + (size_t)nxt.pn * tstep : cB;
        for (int t = 0; t < nt; t += 2) {
            const bool last = (t == nt - 2);
            const char* a1 = cA + (size_t)(t + 1) * kstep;
            const char* a2 = last ? nA : cA + (size_t)(t + 2) * kstep; const char* b2 = last ? nB : cB + (size_t)(t + 2) * kstep;
            const char* a3 = a2 + kstep; const char* b3 = b2 + kstep;
            if (last && has_next) S.a_ready(nxt);
            if constexpr (SP2) {
            PG8_LDB(B0, 0, 0); PG8_LDB(B1, 0, 1); PG8_SCHED; PG8_LDA(At, 0, 0); PG8_STAGE(PG8_SA(1, 1), a1 + hstep, voffA);
            PG8_WAIT_V(8); PG8_WAIT_L(0); PG8_BAR; PG8_MMA(0, 0, At, B0); PG8_MMA(0, 1, At, B1); PG8_BAR; PG8_SCHED;
            PG8_LDA(At, 0, 1); PG8_STAGE(PG8_SB(0, 0), b2, voffB); PG8_STAGE(PG8_SB(0, 1), b2 + hstep, voffB); PG8_STAGE(PG8_SA(0, 0), a2, voffA);
            PG8_WAIT_V(8); PG8_WAIT_L(0); PG8_BAR; PG8_MMA(1, 0, At, B0); PG8_MMA(1, 1, At, B1); PG8_BAR; PG8_SCHED;
            PG8_LDB(B0, 1, 0); PG8_LDB(B1, 1, 1); PG8_SCHED; PG8_LDA(At, 1, 0); PG8_STAGE(PG8_SA(0, 1), a2 + hstep, voffA);
            PG8_WAIT_V(8); PG8_WAIT_L(0); PG8_BAR; PG8_MMA(0, 0, At, B0); PG8_MMA(0, 1, At, B1); PG8_BAR; PG8_SCHED;
            PG8_LDA(At, 1, 1); PG8_STAGE(PG8_SB(1, 0), b3, voffB); PG8_STAGE(PG8_SB(1, 1), b3 + hstep, voffB); PG8_STAGE(PG8_SA(1, 0), a3, voffA);
            PG8_WAIT_V(8); PG8_WAIT_L(0); PG8_BAR; PG8_MMA(1, 0, At, B0); PG8_MMA(1, 1, At, B1); PG8_BAR; PG8_SCHED;
            } else {
            PG8_LDB(B0, 0, 0); PG8_SCHED; PG8_LDA(At, 0, 0); PG8_STAGE(PG8_SA(1, 1), a1 + hstep, voffA);
            PG8_WAIT_L(8); PG8_BAR; PG8_WAIT_L(0); PG8_MMA(0, 0, At, B0); PG8_BAR; PG8_SCHED;
            PG8_LDB(B1, 0, 1); PG8_STAGE(PG8_SB(0, 0), b2, voffB);
            PG8_BAR; PG8_WAIT_L(0); PG8_MMA(0, 1, At, B1); PG8_BAR;
            PG8_LDA(At, 0, 1); PG8_STAGE(PG8_SA(0, 0), a2, voffA);
            PG8_BAR; PG8_WAIT_L(0); PG8_MMA(1, 0, At, B0); PG8_BAR; PG8_SCHED;
            PG8_STAGE(PG8_SB(0, 1), b2 + hstep, voffB);
            PG8_WAIT_V(6); PG8_BAR; PG8_MMA(1, 1, At, B1); PG8_BAR;
            PG8_LDB(B0, 1, 0); PG8_SCHED; PG8_LDA(At, 1, 0); PG8_STAGE(PG8_SA(0, 1), a2 + hstep, voffA);
            PG8_WAIT_L(8); PG8_BAR; PG8_WAIT_L(0); PG8_MMA(0, 0, At, B0); PG8_BAR; PG8_SCHED;
            PG8_LDB(B1, 1, 1); PG8_STAGE(PG8_SB(1, 0), b3, voffB);
            PG8_BAR; PG8_WAIT_L(0); PG8_MMA(0, 1, At, B1); PG8_BAR;
            PG8_LDA(At, 1, 1); PG8_STAGE(PG8_SA(1, 0), a3, voffA);
            PG8_BAR; PG8_WAIT_L(0); PG8_MMA(1, 0, At, B0); PG8_BAR; PG8_SCHED;
            PG8_STAGE(PG8_SB(1, 1), b3 + hstep, voffB);
            PG8_WAIT_V(6); PG8_BAR; PG8_MMA(1, 1, At, B1); PG8_BAR;
            }
        }
        if constexpr (ALIGN_EPI) { if (wr == 0) PG8_BAR; }
        if constexpr (!Epi::AFTER_DRAIN) { E(acc, cur, wr, wc, fr, fq); S.done(cur); }
        if (!has_next) break;
#pragma unroll
        for (int a = 0; a < 2; ++a)
#pragma unroll
            for (int b = 0; b < 2; ++b)
#pragma unroll
                for (int m = 0; m < 4; ++m)
#pragma unroll
                    for (int n = 0; n < 2; ++n) acc[a][b][m][n] = (f32x4){0.f, 0.f, 0.f, 0.f};
        cur = nxt; cA = nA; cB = nB; ++ui;
        if constexpr (ALIGN_EPI) { if (wr == 1) PG8_BAR; }
    }
    PG8_WAIT_V(0);
    if constexpr (!ALIGN_EPI) { if (wr == 0) PG8_BAR; }
    PG8_BAR;
    if constexpr (Epi::AFTER_DRAIN) { E.fused(acc, cur, wr, wc, fr, fq, lds, wid, lane); S.done(cur); }
#undef PG8_SA
#undef PG8_SB
#undef PG8_STAGE
#undef PG8_LDA
#undef PG8_LDB
#undef PG8_MMA
#undef PG8_WAIT_V
#undef PG8_WAIT_L
#undef PG8_BAR
#undef PG8_SCHED
}
}

#ifndef PG8_SP2
#define PG8_SP2 true
#endif
#ifndef PG8_ALIGN
#define PG8_ALIGN true
#endif

#define LAS __attribute__((address_space(3)))
typedef unsigned short bf16_t;
typedef short bf16x8 __attribute__((ext_vector_type(8)));
typedef short s16x4 __attribute__((ext_vector_type(4)));
typedef float f32x4 __attribute__((ext_vector_type(4)));
typedef float f32x2 __attribute__((ext_vector_type(2)));
typedef float f32x16 __attribute__((ext_vector_type(16)));
typedef unsigned u32x4 __attribute__((ext_vector_type(4)));
typedef unsigned u32x2 __attribute__((ext_vector_type(2)));
typedef __bf16 bf16x2_t __attribute__((ext_vector_type(2)));
typedef LAS unsigned char* ldsp;

constexpr int T = 16384, SEQ = 4096, NB = 4, D = 1024, DFF = 2816, NUP = 5632, MEMT = 1024;
constexpr float EPS = 1e-6f, LOG2E = 1.4426950408889634f;
constexpr size_t MiB = 1u << 20;
constexpr size_t WS_CTL = 0, WS_MISC = 65536;
constexpr size_t WS_WIN0 = 1 * MiB, WS_WOUT0 = 7 * MiB, WS_WQ = 9 * MiB, WS_WKV = 13 * MiB, WS_WO = 21 * MiB, WS_WUP = 25 * MiB, WS_WDN = 47 * MiB, WS_WIN1 = 58 * MiB, WS_WOUT1 = 64 * MiB;
constexpr size_t WS_SSQ = 66 * MiB, WS_SSQM = 67 * MiB, WS_GATE = 68 * MiB, WS_MEMB = 69 * MiB, WS_KV = 71 * MiB, WS_CH = 79 * MiB, WS_NST = 79 * MiB + 512 * 1024;
constexpr size_t WS_XB = 80 * MiB, WS_R2 = 112 * MiB, WS_R1 = 144 * MiB, WS_END = 240 * MiB;
constexpr size_t WS_CWP = 79 * MiB + 64 * 1024;
constexpr int LDS_BYTES = 159744, LDS_X = 131072, LDS_RSTAB = LDS_X + 12544, LDS_CWPS = LDS_X + 18688;

__device__ __forceinline__ unsigned cvtpk(float lo, float hi) { f32x2 v = {lo, hi}; bf16x2_t b = __builtin_convertvector(v, bf16x2_t); return __builtin_bit_cast(unsigned, b); }
__device__ __forceinline__ float bflo(unsigned u) { return __uint_as_float(u << 16); }
__device__ __forceinline__ float bfhi(unsigned u) { return __uint_as_float(u & 0xffff0000u); }
__device__ __forceinline__ float bf2f(bf16_t v) { return __uint_as_float(((unsigned)v) << 16); }
__device__ __forceinline__ bf16_t f2bf(float f) { return (bf16_t)(cvtpk(f, 0.f) & 0xffffu); }
__device__ __forceinline__ float wave_sum(float v) {
#pragma unroll
    for (int o = 1; o < 64; o <<= 1) v += __shfl_xor(v, o);
    return v;
}
__device__ __forceinline__ float ex2(float x) { return __builtin_amdgcn_exp2f(x); }
__device__ __forceinline__ float log_sigmoid(float z) { return fminf(z, 0.f) - __logf(1.f + __expf(-fabsf(z))); }
__device__ __forceinline__ float ror1(float v) { return __builtin_bit_cast(float, __builtin_amdgcn_update_dpp(0, __builtin_bit_cast(int, v), 0x121, 0xf, 0xf, false)); }
__device__ __forceinline__ float ror2(float v) { return __builtin_bit_cast(float, __builtin_amdgcn_update_dpp(0, __builtin_bit_cast(int, v), 0x122, 0xf, 0xf, false)); }
__device__ __forceinline__ float gelu_tanh(float x) { return x * __builtin_amdgcn_rcpf(1.f + ex2(-2.302208198f * (x + 0.044715f * x * x * x))); }
__device__ __forceinline__ int crow(int r, int h) { return (r & 3) + 8 * (r >> 2) + 4 * h; }
typedef short v4i16_t __attribute__((ext_vector_type(4)));
__device__ __forceinline__ bf16x8 tr8(ldsp p, int hi_off) {
    s16x4 lo = __builtin_bit_cast(s16x4, __builtin_amdgcn_ds_read_tr16_b64_v4i16((LAS v4i16_t*)p));
    s16x4 hi = __builtin_bit_cast(s16x4, __builtin_amdgcn_ds_read_tr16_b64_v4i16((LAS v4i16_t*)(p + hi_off)));
    return __builtin_shufflevector(lo, hi, 0, 1, 2, 3, 4, 5, 6, 7);
}
__device__ __forceinline__ bf16x8 pack8(const f32x16& x, int s) {
    u32x4 p; p.x = cvtpk(x[8 * s], x[8 * s + 1]); p.y = cvtpk(x[8 * s + 2], x[8 * s + 3]); p.z = cvtpk(x[8 * s + 4], x[8 * s + 5]); p.w = cvtpk(x[8 * s + 6], x[8 * s + 7]);
    return __builtin_bit_cast(bf16x8, p);
}
__device__ __forceinline__ int otid() { int t = threadIdx.x; asm volatile("" : "+v"(t)); return t; }
#define MFMA32(a, b, c) __builtin_amdgcn_mfma_f32_32x32x16_bf16((a), (b), (c), 0, 0, 0)

__device__ __forceinline__ float rstd_from_ssq(const float* ssq, int row) {
    const f32x4* p = (const f32x4*)(ssq + (size_t)row * 16);
    f32x4 a = p[0], b = p[1], c = p[2], d = p[3];
    float s = ((a.x + a.y) + (a.z + a.w)) + ((b.x + b.y) + (b.z + b.w)) + ((c.x + c.y) + (c.z + c.w)) + ((d.x + d.y) + (d.z + d.w));
    return rsqrtf(s * (1.0f / 1024.0f) + EPS);
}
struct EpiScaled {
    static constexpr bool PERM = true, AFTER_DRAIN = false;
    bf16_t* O; int plane_cols; size_t plane_stride; int ldc; const float* ssq; float qscale; unsigned qmask;
    __device__ __forceinline__ void operator()(const f32x4 (&acc)[2][2][4][2], const pg8::Unit& u, int wr, int wc, int fr, int fq) const {
        const int row0 = u.pm * 256 + wr * 64 + fr;
#pragma unroll
        for (int ai = 0; ai < 2; ++ai)
#pragma unroll
            for (int m = 0; m < 4; ++m) {
                const int row = row0 + ai * 128 + m * 16;
                const float rs = rstd_from_ssq(ssq, row);
#pragma unroll
                for (int bj = 0; bj < 2; ++bj) {
                    const int c = u.pn * 256 + 128 * bj + 32 * wc + 8 * fq;
                    const int pl = c / plane_cols, cc = c - pl * plane_cols;
                    const float sc = ((qmask >> pl) & 1u) ? rs * qscale : rs;
                    const f32x4 v0 = acc[ai][bj][m][0] * sc, v1 = acc[ai][bj][m][1] * sc;
                    u32x4 w; w.x = cvtpk(v0[0], v0[1]); w.y = cvtpk(v0[2], v0[3]); w.z = cvtpk(v1[0], v1[1]); w.w = cvtpk(v1[2], v1[3]);
                    *(u32x4*)(O + (size_t)pl * plane_stride + (size_t)row * ldc + cc) = w;
                }
            }
    }
};
struct EpiScaledT {
    static constexpr bool PERM = true, AFTER_DRAIN = false;
    bf16_t* O; int plane_cols; size_t plane_stride; int ldc; const LAS float* rstab; float qscale; unsigned qmask; mutable int ord = 0;
    __device__ __forceinline__ void operator()(const f32x4 (&acc)[2][2][4][2], const pg8::Unit& u, int wr, int wc, int fr, int fq) const {
        const int row0 = u.pm * 256 + wr * 64 + fr;
        const int o = ord++;
#pragma unroll
        for (int ai = 0; ai < 2; ++ai)
#pragma unroll
            for (int m = 0; m < 4; ++m) {
                const int row = row0 + ai * 128 + m * 16;
                const float rs = rstab[o * 256 + (row & 255)];
#pragma unroll
                for (int bj = 0; bj < 2; ++bj) {
                    const int c = u.pn * 256 + 128 * bj + 32 * wc + 8 * fq;
                    const int pl = c / plane_cols, cc = c - pl * plane_cols;
                    const float sc = ((qmask >> pl) & 1u) ? rs * qscale : rs;
                    const f32x4 v0 = acc[ai][bj][m][0] * sc, v1 = acc[ai][bj][m][1] * sc;
                    u32x4 w; w.x = cvtpk(v0[0], v0[1]); w.y = cvtpk(v0[2], v0[3]); w.z = cvtpk(v1[0], v1[1]); w.w = cvtpk(v1[2], v1[3]);
                    *(u32x4*)(O + (size_t)pl * plane_stride + (size_t)row * ldc + cc) = w;
                }
            }
    }
};
struct EpiRes {
    static constexpr bool PERM = true, AFTER_DRAIN = false;
    const float* basef; bf16_t* xb; float* ssq;
    __device__ __forceinline__ void operator()(const f32x4 (&acc)[2][2][4][2], const pg8::Unit& u, int wr, int wc, int fr, int fq) const {
        const int row0 = u.pm * 256 + wr * 64 + fr;
#pragma unroll
        for (int ai = 0; ai < 2; ++ai)
#pragma unroll
            for (int m = 0; m < 4; ++m) {
                const int row = row0 + ai * 128 + m * 16;
                float ss = 0.f;
#pragma unroll
                for (int bj = 0; bj < 2; ++bj) {
                    const int c = u.pn * 256 + 128 * bj + 32 * wc + 8 * fq;
                    const size_t off = (size_t)row * D + c;
                    f32x4 b0, b1;
                    if (basef) { b0 = *(const f32x4*)(basef + off); b1 = *(const f32x4*)(basef + off + 4); }
                    else { const u32x4 r = *(const u32x4*)(xb + off); b0 = (f32x4){bflo(r.x), bfhi(r.x), bflo(r.y), bfhi(r.y)}; b1 = (f32x4){bflo(r.z), bfhi(r.z), bflo(r.w), bfhi(r.w)}; }
                    const f32x4 v0 = b0 + acc[ai][bj][m][0], v1 = b1 + acc[ai][bj][m][1];
                    u32x4 w; w.x = cvtpk(v0[0], v0[1]); w.y = cvtpk(v0[2], v0[3]); w.z = cvtpk(v1[0], v1[1]); w.w = cvtpk(v1[2], v1[3]);
                    *(u32x4*)(xb + off) = w;
                    const float q0 = bflo(w.x), q1 = bfhi(w.x), q2 = bflo(w.y), q3 = bfhi(w.y), q4 = bflo(w.z), q5 = bfhi(w.z), q6 = bflo(w.w), q7 = bfhi(w.w);
                    ss += (q0 * q0 + q1 * q1) + (q2 * q2 + q3 * q3) + (q4 * q4 + q5 * q5) + (q6 * q6 + q7 * q7);
                }
                ss += __shfl_xor(ss, 16); ss += __shfl_xor(ss, 32);
                if (fq == 0) ssq[(size_t)row * 16 + u.pn * 4 + wc] = ss;
            }
    }
};

__device__ __forceinline__ float shr1(float v) { return __builtin_bit_cast(float, __builtin_amdgcn_update_dpp(0, __builtin_bit_cast(int, v), 0x111, 0xf, 0xf, true)); }
struct EpiUp {
    static constexpr bool PERM = true, AFTER_DRAIN = false, APERM = true;
    bf16_t* act; float* head; float* tail; const float* ssq; const float* cwp; const LAS float* rstab; LAS float* cwps; mutable int ord = 0;
    __device__ __forceinline__ void operator()(const f32x4 (&acc)[2][2][4][2], const pg8::Unit& u, int wr, int wc, int fr, int fq) const {
        const int j0 = u.pn * 128 + 32 * wc + 8 * fq;
        const int o = ord++;
        LAS float* cs = cwps + (wr * 4 + wc) * 256;
        *(LAS f32x4*)(cs + (fq * 16 + fr) * 4) = *(const f32x4*)(cwp + (size_t)(u.pn * 128 + 32 * wc) * 8 + (fq * 16 + fr) * 4);
#pragma unroll
        for (int ai = 0; ai < 2; ++ai) {
            const int grp = u.pm * 4 + ai * 2 + wr;
            float rs[4];
#pragma unroll
            for (int m = 0; m < 4; ++m) rs[m] = rstab[o * 256 + ((grp & 3) * 64 + 4 * fr + m)];
#pragma unroll
            for (int n = 0; n < 2; ++n) {
                unsigned res[4][2];
#pragma unroll
                for (int ep = 0; ep < 2; ++ep) {
                    const LAS f32x4* cq = (const LAS f32x4*)(cs + (4 * fq + 2 * n + ep) * 16);
                    const f32x4 A0 = cq[0], A1 = cq[1], A2 = cq[2], A3 = cq[3];
                    const f32x2 W0g = {A0[0], A0[1]}, W1g = {A0[2], A0[3]}, W2g = {A1[0], A1[1]}, Bg = {A1[2], A1[3]};
                    const f32x2 W0u = {A2[0], A2[1]}, W1u = {A2[2], A2[3]}, W2u = {A3[0], A3[1]}, Bu = {A3[2], A3[3]};
                    f32x2 Gv[4], Uv[4];
#pragma unroll
                    for (int m = 0; m < 4; ++m) { Gv[m] = (f32x2){acc[ai][0][m][n][2 * ep], acc[ai][0][m][n][2 * ep + 1]} * rs[m]; Uv[m] = (f32x2){acc[ai][1][m][n][2 * ep], acc[ai][1][m][n][2 * ep + 1]} * rs[m]; }
                    const f32x2 g3s = {shr1(Gv[3].x), shr1(Gv[3].y)}, g2s = {shr1(Gv[2].x), shr1(Gv[2].y)}, u3s = {shr1(Uv[3].x), shr1(Uv[3].y)}, u2s = {shr1(Uv[2].x), shr1(Uv[2].y)};
                    f32x2 hg[4], hu[4];
                    hg[0] = W0g * g2s + W1g * g3s + W2g * Gv[0] + Bg;     hu[0] = W0u * u2s + W1u * u3s + W2u * Uv[0] + Bu;
                    hg[1] = W0g * g3s + W1g * Gv[0] + W2g * Gv[1] + Bg;   hu[1] = W0u * u3s + W1u * Uv[0] + W2u * Uv[1] + Bu;
                    hg[2] = W0g * Gv[0] + W1g * Gv[1] + W2g * Gv[2] + Bg; hu[2] = W0u * Uv[0] + W1u * Uv[1] + W2u * Uv[2] + Bu;
                    hg[3] = W0g * Gv[1] + W1g * Gv[2] + W2g * Gv[3] + Bg; hu[3] = W0u * Uv[1] + W1u * Uv[2] + W2u * Uv[3] + Bu;
                    const int j = j0 + 4 * n + 2 * ep;
                    if (fr == 0) { float* hp = head + (size_t)(grp * 2) * NUP + j; *(f32x2*)hp = Gv[0]; *(f32x2*)(hp + DFF) = Uv[0]; *(f32x2*)(hp + NUP) = Gv[1]; *(f32x2*)(hp + NUP + DFF) = Uv[1]; }
                    if (fr == 15) { float* tp = tail + (size_t)(grp * 2) * NUP + j; *(f32x2*)tp = Gv[2]; *(f32x2*)(tp + DFF) = Uv[2]; *(f32x2*)(tp + NUP) = Gv[3]; *(f32x2*)(tp + NUP + DFF) = Uv[3]; }
#pragma unroll
                    for (int m = 0; m < 4; ++m) {
                        const f32x2 x = hg[m], t = x * (x * x * 0.044715f + 1.0f) * (-2.302208198f);
                        const f32x2 den = (f32x2){ex2(t.x), ex2(t.y)} + 1.0f;
                        const f32x2 val = x * hu[m] * (f32x2){__builtin_amdgcn_rcpf(den.x), __builtin_amdgcn_rcpf(den.y)};
                        res[m][ep] = cvtpk(val.x, val.y);
                    }
                }
#pragma unroll
                for (int m = 0; m < 4; ++m) {
                    if (m >= 2 || fr > 0) { u32x2 w; w.x = res[m][0]; w.y = res[m][1];
                        *(u32x2*)(act + (size_t)(grp * 64 + 4 * fr + m) * DFF + j0 + 4 * n) = w; }
                }
                asm volatile("" ::: "memory");
            }
        }
    }
};

template <class Sched>
__device__ __forceinline__ void rstab_fill(ldsp lds, const Sched S, const float* ssq) {
    LAS float* tab = (LAS float*)(lds + LDS_RSTAB);
    const int t = otid();
#pragma unroll
    for (int i = 0; i < 6; ++i) { pg8::Unit fu; if (S.next(i, fu) && t < 256) tab[i * 256 + t] = rstd_from_ssq(ssq, fu.pm * 256 + t); }
    __syncthreads();
}
#define XB_TMO      128
#define XB_XCNT(j)  (256  + 64 * (j))
#define XB_XSUB(j)  (1280 + 64 * (j))
#define XB_XGEN(j)  (2304 + 64 * (j))
#define XB_TOP      3328
#define XB_TOPGEN   3392
#define XCD_BAR_WORDS 3456
#define XB_SPIN_CAP (1u << 18)
__device__ __forceinline__ unsigned xb_ld(unsigned* p)              { return __hip_atomic_load(p, __ATOMIC_RELAXED, __HIP_MEMORY_SCOPE_AGENT); }
__device__ __forceinline__ unsigned xb_add(unsigned* p, unsigned v) { return __hip_atomic_fetch_add(p, v, __ATOMIC_RELAXED, __HIP_MEMORY_SCOPE_AGENT); }
__device__ __forceinline__ unsigned xb_xcc_id() { return (unsigned)__builtin_amdgcn_s_getreg((3 << 11) | 20) & 0xFu; }
#define XB_SPIN(cond, bar) do { unsigned _sp = 0; while (cond) { __builtin_amdgcn_s_sleep(1); \
    if ((++_sp & 255u) == 0u) { if (xb_ld(&(bar)[XB_TMO])) break; if (_sp > XB_SPIN_CAP) { atomicAdd(&(bar)[XB_TMO], 1u); break; } } } } while (0)

struct XcdBarrier {
    unsigned* bar; unsigned x;
    volatile LAS unsigned* st;
};

__device__ __forceinline__ XcdBarrier xcd_barrier_post(unsigned* bar, volatile LAS unsigned* st) {
    XcdBarrier b; b.bar = bar; b.x = xb_xcc_id(); b.st = st;
    if (threadIdx.x == 0) (void)xb_add(&bar[XB_XCNT(b.x)], 1u);
    return b;
}
__device__ __forceinline__ void xcd_barrier_complete(unsigned* bar, unsigned x, unsigned& nloc, unsigned& nx) {
    const unsigned G = gridDim.x * gridDim.y * gridDim.z;
    unsigned sum, cnt, mine, sp = 0u;
    for (;;) {
        sum = 0u; cnt = 0u; mine = 0u;
#pragma unroll
        for (unsigned j = 0; j < 16; ++j) { const unsigned c = xb_ld(&bar[XB_XCNT(j)]); sum += c; cnt += (c > 0u) ? 1u : 0u; mine = (j == x) ? c : mine; }
        if (sum == G) break;
        __builtin_amdgcn_s_sleep(1);
        if ((++sp & 255u) == 0u) { if (xb_ld(&bar[XB_TMO])) break; if (sp > XB_SPIN_CAP) { atomicAdd(&bar[XB_TMO], 1u); break; } }
    }
    nloc = mine > 0u ? mine : 1u; nx = cnt > 0u ? cnt : 1u;
}

__device__ __forceinline__ void xcd_barrier(const XcdBarrier& b) {
    asm volatile("s_waitcnt vmcnt(0)" ::: "memory");
    __syncthreads();
    if (threadIdx.x == 0) {
        unsigned* bar = b.bar;
        __builtin_amdgcn_s_waitcnt(0);
        unsigned nloc = b.st[0], nx = b.st[1];
        if (nloc == 0u) { xcd_barrier_complete(bar, b.x, nloc, nx); b.st[0] = nloc; b.st[1] = nx; }
        const unsigned old = xb_add(&bar[XB_XSUB(b.x)], 1u);
        const unsigned gen = old / nloc;
        if (old + 1u == (gen + 1u) * nloc) {
            __builtin_amdgcn_fence(__ATOMIC_RELEASE, "agent");
            asm volatile("s_waitcnt vmcnt(0)" ::: "memory");
            const unsigned og = xb_add(&bar[XB_TOP], 1u);
            const unsigned tg = og / nx;
            if (og + 1u == (tg + 1u) * nx) xb_add(&bar[XB_TOPGEN], 1u);
            else XB_SPIN(xb_ld(&bar[XB_TOPGEN]) == tg, bar);
            __builtin_amdgcn_fence(__ATOMIC_ACQUIRE, "agent");
            xb_add(&bar[XB_XGEN(b.x)], 1u);
            asm volatile("s_waitcnt vmcnt(0)" ::: "memory");
        } else {
            XB_SPIN(xb_ld(&bar[XB_XGEN(b.x)]) == gen, bar);
            __builtin_amdgcn_fence(__ATOMIC_ACQUIRE, "agent");
            asm volatile("s_waitcnt vmcnt(0)" ::: "memory");
        }
    }
    __syncthreads();
}


struct Args { const float* in[28]; float* out; unsigned char* ws; };

__device__ __forceinline__ void wt_item(const float* W, int K, int Nsrc, int srccol0, bf16_t* WT, int dstrow0, const float* gain, int k0, ldsp scr, int lane) {
    const int c4 = lane & 15, rr = lane >> 4;
    f32x4 w[16];
#pragma unroll
    for (int i = 0; i < 16; ++i) w[i] = *(const f32x4*)(W + (size_t)(k0 + 4 * i + rr) * Nsrc + srccol0 + 4 * c4);
#pragma unroll
    for (int i = 0; i < 16; ++i) { const float g = gain ? gain[k0 + 4 * i + rr] : 1.f; const unsigned a = cvtpk(w[i].x * g, w[i].y * g), b = cvtpk(w[i].z * g, w[i].w * g);
        ldsp p = scr + (4 * c4) * 132 + (4 * i + rr) * 2;
        *(LAS bf16_t*)(p) = (bf16_t)(a & 0xffffu); *(LAS bf16_t*)(p + 132) = (bf16_t)(a >> 16); *(LAS bf16_t*)(p + 264) = (bf16_t)(b & 0xffffu); *(LAS bf16_t*)(p + 396) = (bf16_t)(b >> 16); }
    asm volatile("s_waitcnt lgkmcnt(0)" ::: "memory");
    const int c = lane & 7;
#pragma unroll
    for (int j = 0; j < 8; ++j) { const int n = 8 * j + (lane >> 3); const LAS unsigned* s = (const LAS unsigned*)(scr + n * 132 + c * 16);
        u32x4 o; o.x = s[0]; o.y = s[1]; o.z = s[2]; o.w = s[3];
        *(u32x4*)(WT + (size_t)(dstrow0 + n) * K + k0 + 8 * c) = o; }
    asm volatile("s_waitcnt lgkmcnt(0)" ::: "memory");
}
__device__ __forceinline__ void wt_dispatch(const Args& A, int it, ldsp scr, int lane) {
    const float* W; bf16_t* WT; const float* gain = nullptr; int K = 1024, Nsrc, Ndst, mode = 0, r = it;
    unsigned char* ws = A.ws;
    if (r < 768) { W = A.in[6]; WT = (bf16_t*)(ws + WS_WIN0); gain = A.in[2]; Nsrc = 3080; Ndst = 3072; mode = 1; }
    else if ((r -= 768) < 256) { W = A.in[13]; WT = (bf16_t*)(ws + WS_WOUT0); Nsrc = 1024; Ndst = 1024; }
    else if ((r -= 256) < 512) { const int l = r / 256; r -= l * 256; W = A.in[20] + (size_t)l * 1024 * 1024; WT = (bf16_t*)(ws + WS_WQ) + (size_t)l * 1024 * 1024; gain = A.in[3] + l * 1024; Nsrc = 1024; Ndst = 1024; }
    else if ((r -= 512) < 1024) { const int l = r / 512; r -= l * 512; W = A.in[21] + (size_t)l * 1024 * 2048; WT = (bf16_t*)(ws + WS_WKV) + (size_t)l * 2048 * 1024; gain = A.in[4] + l * 1024; Nsrc = 2048; Ndst = 2048; }
    else if ((r -= 1024) < 512) { const int l = r / 256; r -= l * 256; W = A.in[22] + (size_t)l * 1024 * 1024; WT = (bf16_t*)(ws + WS_WO) + (size_t)l * 1024 * 1024; Nsrc = 1024; Ndst = 1024; }
    else if ((r -= 512) < 2816) { const int l = r / 1408; r -= l * 1408; W = A.in[23] + (size_t)l * 1024 * NUP; WT = (bf16_t*)(ws + WS_WUP) + (size_t)l * NUP * 1024; gain = A.in[5] + l * 1024; Nsrc = NUP; Ndst = NUP; mode = 3; }
    else if ((r -= 2816) < 1408) { const int l = r / 704; r -= l * 704; W = A.in[26] + (size_t)l * DFF * 1024; WT = (bf16_t*)(ws + WS_WDN) + (size_t)l * 1024 * DFF; K = DFF; Nsrc = 1024; Ndst = 1024; }
    else if ((r -= 1408) < 768) { W = A.in[14]; WT = (bf16_t*)(ws + WS_WIN1); gain = A.in[2] + 1024; Nsrc = 3080; Ndst = 3072; mode = 2; }
    else { r -= 768; W = A.in[19]; WT = (bf16_t*)(ws + WS_WOUT1); Nsrc = 1024; Ndst = 1024; }
    const int nblk = Ndst / 64, kb = r / nblk, nb = r % nblk, n0 = nb * 64;
    int sc = n0;
    if (mode == 1) sc = n0 < 1536 ? n0 : n0 + 8;
    else if (mode == 2) sc = n0 < 2048 ? n0 : n0 + 8;
    else if (mode == 3) { const int p = n0 >> 8, i = n0 & 255; sc = i < 128 ? 128 * p + i : DFF + 128 * p + (i - 128); }
    wt_item(W, K, Nsrc, sc, WT, n0, gain, kb * 64, scr, lane);
}
constexpr int WT_ITEMS = 8320;

template <int MODE>
__device__ __forceinline__ void row_pass(const Args& A, ldsp lds, const float* X, const float* Wg, int col0, const float* gain, int gw, int ngw, int tid, int lane) {
    LAS float* gwl = (LAS float*)lds;
    for (int i = tid; i < 1024 * 2; i += 512) { const int k = i >> 1, hf = i & 1; const f32x4 w = *(const f32x4*)(Wg + (size_t)k * 3080 + col0 + 4 * hf); const float g = gain[k];
        gwl[(4 * hf + 0) * 1024 + k] = w.x * g; gwl[(4 * hf + 1) * 1024 + k] = w.y * g; gwl[(4 * hf + 2) * 1024 + k] = w.z * g; gwl[(4 * hf + 3) * 1024 + k] = w.w * g; }
    __syncthreads();
    unsigned char* ws = A.ws;
    bf16_t* xb = (bf16_t*)(ws + WS_XB); float* ssq = (float*)(ws + WS_SSQ); float* gate = (float*)(ws + WS_GATE);
    f32x4 nx[4];
    if (gw < T) {
#pragma unroll
        for (int j = 0; j < 4; ++j) nx[j] = ((const f32x4*)(X + (size_t)gw * D) + lane)[64 * j];
    }
    for (int m = gw; m < T; m += ngw) {
        f32x4 v[4]; float s = 0.f;
#pragma unroll
        for (int j = 0; j < 4; ++j) { v[j] = nx[j]; s += (v[j].x * v[j].x + v[j].y * v[j].y) + (v[j].z * v[j].z + v[j].w * v[j].w); }
        if (m + ngw < T) {
#pragma unroll
            for (int j = 0; j < 4; ++j) nx[j] = ((const f32x4*)(X + (size_t)(m + ngw) * D) + lane)[64 * j];
        }
        s = wave_sum(s);
        const float rstd = rsqrtf(s * (1.0f / 1024.0f) + EPS);
        if (MODE == 0) {
            u32x2* o8 = (u32x2*)(xb + (size_t)m * D) + lane;
#pragma unroll
            for (int j = 0; j < 4; ++j) { u32x2 w; w.x = cvtpk(v[j].x, v[j].y); w.y = cvtpk(v[j].z, v[j].w); o8[64 * j] = w; }
            if (lane < 16) ssq[(size_t)m * 16 + lane] = lane == 0 ? s : 0.f;
        }
        float z[8];
#pragma unroll
        for (int c = 0; c < 8; ++c) { float d = 0.f;
#pragma unroll
            for (int j = 0; j < 4; ++j) { const f32x4 w = *(const LAS f32x4*)(gwl + c * 1024 + 256 * j + 4 * lane); d += (v[j].x * w.x + v[j].y * w.y) + (v[j].z * w.z + v[j].w * w.w); }
            z[c] = wave_sum(d) * rstd; }
        float zc = z[0];
#pragma unroll
        for (int c = 1; c < 8; ++c) zc = lane == c ? z[c] : zc;
        const int b = m >> 12, t = m & 4095;
        if (MODE == 0) { if (lane < 8) gate[(size_t)(b * 8 + lane) * SEQ + t] = log_sigmoid(zc + A.in[7][lane]); }
        else { if (lane < 4) gate[(size_t)(b * 4 + lane) * SEQ + t] = zc + A.in[16][lane];
               else if (lane < 8) gate[(size_t)(16 + b * 4 + lane - 4) * SEQ + t] = log_sigmoid(zc + A.in[17][lane - 4]); }
    }
    __syncthreads();
}

__device__ __forceinline__ void seq_cumsum(float* p, float scale, LAS float* scr, int tid, int lane, int wid) {
    f32x4 a = ((const f32x4*)p)[2 * tid], b = ((const f32x4*)p)[2 * tid + 1];
    a.y += a.x; a.z += a.y; a.w += a.z; b.x += a.w; b.y += b.x; b.z += b.y; b.w += b.z;
    float tot = b.w, inc = tot;
#pragma unroll
    for (int o = 1; o < 64; o <<= 1) { const float n = __shfl_up(inc, o); if (lane >= o) inc += n; }
    if (lane == 63) scr[wid] = inc;
    __syncthreads();
    float pre = inc - tot;
    for (int w = 0; w < wid; ++w) pre += scr[w];
    a = (a + pre) * scale; b = (b + pre) * scale;
    ((f32x4*)p)[2 * tid] = a; ((f32x4*)p)[2 * tid + 1] = b;
    __syncthreads();
}

__device__ __forceinline__ float xhalf_max(float m) { const auto rr = __builtin_amdgcn_permlane32_swap(__float_as_uint(m), __float_as_uint(m), false, false); return fmaxf(__uint_as_float(rr[0]), __uint_as_float(rr[1])); }
__device__ __forceinline__ float max3f(float a, float b, float c) { float r; asm("v_max3_f32 %0, %1, %2, %3" : "=v"(r) : "v"(a), "v"(b), "v"(c)); return r; }
template <int DQK, int DV, int MODE> struct FC {
    static constexpr int KT = (MODE == 1) ? 128 : 64;
    static constexpr int PK = DQK * 2 + 16, PV = DV * 2 + 64, KB = KT * PK, VB = KT * PV, STAGE = KB + VB + KT * 4;
    static constexpr int NCK = KT * DQK / 8 / 512, NCV = KT * DV / 8 / 512;
};
template <int DQK, int DV, int MODE, int NCK, int NCV>
__device__ __forceinline__ void fl_gload(u32x4 (&kr)[NCK], u32x4 (&vr)[NCV], float& fr_, const bf16_t* K, int kp, const bf16_t* V, int vp, const float* Fl, int kv0, int tid, int part = 3) {
    if (part & 1)
#pragma unroll
    for (int i = 0; i < NCK; ++i) { const int cid = tid + 512 * i, row = cid / (DQK / 8), cc = cid % (DQK / 8); kr[i] = *(const u32x4*)(K + (size_t)(kv0 + row) * kp + cc * 8); }
    if (part & 2)
#pragma unroll
    for (int i = 0; i < NCV; ++i) { const int cid = tid + 512 * i, row = cid / (DV / 8), cc = cid % (DV / 8); vr[i] = *(const u32x4*)(V + (size_t)(kv0 + row) * vp + cc * 8); }
    if (MODE == 1 && (part & 1)) { if (tid < FC<DQK, DV, MODE>::KT) fr_ = Fl[kv0 + tid]; }
}
template <int DQK, int DV, int MODE, int NCK, int NCV>
__device__ __forceinline__ void fl_sstore(ldsp st, const u32x4 (&kr)[NCK], const u32x4 (&vr)[NCV], float fr_, int tid) {
    typedef FC<DQK, DV, MODE> C;
#pragma unroll
    for (int i = 0; i < C::NCK; ++i) { const int cid = tid + 512 * i, row = cid / (DQK / 8), cc = cid % (DQK / 8); *(LAS u32x4*)(st + row * C::PK + cc * 16) = kr[i]; }
#pragma unroll
    for (int i = 0; i < C::NCV; ++i) { const int cid = tid + 512 * i, row = cid / (DV / 8), cc = cid % (DV / 8); *(LAS u32x4*)(st + C::KB + row * C::PV + cc * 16) = vr[i]; }
    if (MODE == 1) { if (tid < C::KT) *(LAS float*)(st + C::KB + C::VB + tid * 4) = -fr_; }
}
template <int DQK, int DV, int MODE>
__device__ __forceinline__ void flash_unit(ldsp lds, LAS float* wscr, const bf16_t* Q, int qp, const bf16_t* K, int kp, const bf16_t* V, int vp, const float* Fl,
                                           int q0, int ntiles, f32x16 (&o)[DV / 32]) {
    typedef FC<DQK, DV, MODE> C;
    const int tid = otid(), lane = tid & 63, wid = __builtin_amdgcn_readfirstlane(tid >> 6), n = lane & 31, h = lane >> 5;
    const int i16 = lane & 15, q4 = i16 >> 2, p4 = i16 & 3, blk = (lane >> 4) & 1;
    const int qw = q0 + 32 * wid;
    bf16x8 qf[DQK / 16];
#pragma unroll
    for (int st = 0; st < DQK / 16; ++st) qf[st] = *(const bf16x8*)(Q + (size_t)(qw + n) * qp + 16 * st + 8 * h);
#pragma unroll
    for (int db = 0; db < DV / 32; ++db)
#pragma unroll
        for (int r = 0; r < 16; ++r) o[db][r] = 0.f;
    float mrun = -1e30f, lrun = 0.f;
    const int jmax_w = (MODE == 0) ? ntiles - 1 : (qw >> 6);
    u32x4 kr[C::NCK], vr[C::NCV]; float frg = 0.f;
    fl_gload<DQK, DV, MODE, C::NCK, C::NCV>(kr, vr, frg, K, kp, V, vp, Fl, 0, tid);
    fl_sstore<DQK, DV, MODE, C::NCK, C::NCV>(lds, kr, vr, frg, tid);
    __syncthreads();
    constexpr int SUBS = C::KT / 64;
    for (int j0 = 0; j0 < ntiles; j0 += SUBS) {
        ldsp st = lds + ((j0 / SUBS) & 1) * C::STAGE;
        if (j0 + SUBS < ntiles) fl_gload<DQK, DV, MODE, C::NCK, C::NCV>(kr, vr, frg, K, kp, V, vp, Fl, 64 * (j0 + SUBS), tid, 3);
#pragma unroll
        for (int sub = 0; sub < SUBS; ++sub) {
        const int j = j0 + sub;
        if (j <= jmax_w) {
            f32x16 p0, p1;
            if (MODE == 1) {
                const LAS float* fb = (const LAS float*)(st + C::KB + C::VB) + 64 * sub;
#pragma unroll
                for (int g = 0; g < 4; ++g) { const f32x4 f0 = *(const LAS f32x4*)(fb + 8 * g + 4 * h), f1 = *(const LAS f32x4*)(fb + 32 + 8 * g + 4 * h);
#pragma unroll
                    for (int e = 0; e < 4; ++e) { p0[4 * g + e] = f0[e]; p1[4 * g + e] = f1[e]; } }
            }
            ldsp ka = st + (64 * sub + n) * C::PK + 16 * h;
            const f32x16 zero16 = {0.f, 0.f, 0.f, 0.f, 0.f, 0.f, 0.f, 0.f, 0.f, 0.f, 0.f, 0.f, 0.f, 0.f, 0.f, 0.f};
#pragma unroll
            for (int s = 0; s < DQK / 16; ++s) {
                const bf16x8 a0 = *(const LAS bf16x8*)(ka + 32 * s), a1 = *(const LAS bf16x8*)(ka + 32 * C::PK + 32 * s);
                if (MODE != 1 && s == 0) { p0 = MFMA32(a0, qf[s], zero16); p1 = MFMA32(a1, qf[s], zero16); }
                else { p0 = MFMA32(a0, qf[s], p0); p1 = MFMA32(a1, qf[s], p1); }
            }
            if (MODE == 1) {
                if (j == jmax_w) { const int ql = qw - 64 * j + n;
#pragma unroll
                    for (int r = 0; r < 16; ++r) { const int kvl = crow(r, h); if (kvl > ql) p0[r] = -INFINITY; if (kvl + 32 > ql) p1[r] = -INFINITY; } }
            }
            float mx = fmaxf(p0[0], p1[0]);
#pragma unroll
            for (int r = 1; r < 16; ++r) mx = max3f(mx, p0[r], p1[r]);
            if (MODE == 1) mx = xhalf_max(mx); else mx = fmaxf(mx, __shfl_xor(mx, 32));
            float alpha = 1.0f;
            if (__any(mx - mrun > 8.0f)) {
                const float mnew = fmaxf(mrun, mx); alpha = ex2(mrun - mnew); mrun = mnew;
                wscr[n] = alpha;
                asm volatile("s_waitcnt lgkmcnt(0)" ::: "memory");
#pragma unroll
                for (int g = 0; g < 4; ++g) { const f32x4 a4 = *(const LAS f32x4*)(wscr + 8 * g + 4 * h);
#pragma unroll
                    for (int db = 0; db < DV / 32; ++db)
#pragma unroll
                        for (int e = 0; e < 4; ++e) o[db][4 * g + e] *= a4[e]; }
            }
            f32x2 rs2 = {0.f, 0.f};
#pragma unroll
            for (int r = 0; r < 16; r += 2) {
                const f32x2 a = (f32x2){p0[r], p0[r + 1]} - mrun, b = (f32x2){p1[r], p1[r + 1]} - mrun;
                const f32x2 ea = {ex2(a.x), ex2(a.y)}, eb = {ex2(b.x), ex2(b.y)};
                p0[r] = ea.x; p0[r + 1] = ea.y; p1[r] = eb.x; p1[r + 1] = eb.y;
                rs2 = rs2 + ea + eb;
            }
            lrun = lrun * alpha + (rs2.x + rs2.y);
            ldsp vb = st + C::KB + (64 * sub + 4 * h + q4) * C::PV + blk * 32 + 8 * p4;
#pragma unroll
            for (int ks = 0; ks < 4; ++ks) {
                const bf16x8 pa = (ks & 2) ? pack8(p1, ks & 1) : pack8(p0, ks & 1);
#pragma unroll
                for (int db = 0; db < DV / 32; ++db) {
                    const bf16x8 bv = tr8(vb + (16 * ks) * C::PV + db * 64, 8 * C::PV);
                    o[db] = MFMA32(pa, bv, o[db]);
                }
            }
        }
        }
        if (j0 + SUBS < ntiles) fl_sstore<DQK, DV, MODE, C::NCK, C::NCV>(lds + (((j0 / SUBS) + 1) & 1) * C::STAGE, kr, vr, frg, tid);
        __syncthreads();
    }
    lrun += __shfl_xor(lrun, 32);
    wscr[n] = 1.0f / lrun;
    asm volatile("s_waitcnt lgkmcnt(0)" ::: "memory");
#pragma unroll
    for (int g = 0; g < 4; ++g) { const f32x4 a4 = *(const LAS f32x4*)(wscr + 8 * g + 4 * h);
#pragma unroll
        for (int db = 0; db < DV / 32; ++db)
#pragma unroll
            for (int e = 0; e < 4; ++e) o[db][4 * g + e] *= a4[e]; }
    asm volatile("" ::: "memory");
}

__device__ __forceinline__ void row_gates_b(const Args& A, ldsp lds, const bf16_t* X, const float* Wg, int col0, const float* gain, int gw, int ngw, int tid, int lane) {
    LAS float* gwl = (LAS float*)lds;
    for (int i = tid; i < 1024 * 2; i += 512) { const int k = i >> 1, hf = i & 1; const f32x4 w = *(const f32x4*)(Wg + (size_t)k * 3080 + col0 + 4 * hf); const float g = gain[k];
        gwl[(4 * hf + 0) * 1024 + k] = w.x * g; gwl[(4 * hf + 1) * 1024 + k] = w.y * g; gwl[(4 * hf + 2) * 1024 + k] = w.z * g; gwl[(4 * hf + 3) * 1024 + k] = w.w * g; }
    __syncthreads();
    float* gate = (float*)(A.ws + WS_GATE);
    u32x4 nx[2];
    if (gw < T) { nx[0] = ((const u32x4*)(X + (size_t)gw * D))[lane]; nx[1] = ((const u32x4*)(X + (size_t)gw * D))[64 + lane]; }
    for (int m = gw; m < T; m += ngw) {
        float v[2][8]; float s = 0.f;
#pragma unroll
        for (int j = 0; j < 2; ++j) { const u32x4 r = nx[j];
            v[j][0] = bflo(r.x); v[j][1] = bfhi(r.x); v[j][2] = bflo(r.y); v[j][3] = bfhi(r.y); v[j][4] = bflo(r.z); v[j][5] = bfhi(r.z); v[j][6] = bflo(r.w); v[j][7] = bfhi(r.w);
#pragma unroll
            for (int e = 0; e < 8; ++e) s += v[j][e] * v[j][e]; }
        if (m + ngw < T) { nx[0] = ((const u32x4*)(X + (size_t)(m + ngw) * D))[lane]; nx[1] = ((const u32x4*)(X + (size_t)(m + ngw) * D))[64 + lane]; }
        s = wave_sum(s);
        const float rstd = rsqrtf(s * (1.0f / 1024.0f) + EPS);
        float z[8];
#pragma unroll
        for (int c = 0; c < 8; ++c) { float d = 0.f;
#pragma unroll
            for (int j = 0; j < 2; ++j) { const f32x4 w0 = *(const LAS f32x4*)(gwl + c * 1024 + 512 * j + 8 * lane), w1 = *(const LAS f32x4*)(gwl + c * 1024 + 512 * j + 8 * lane + 4);
                d += (v[j][0] * w0.x + v[j][1] * w0.y) + (v[j][2] * w0.z + v[j][3] * w0.w) + (v[j][4] * w1.x + v[j][5] * w1.y) + (v[j][6] * w1.z + v[j][7] * w1.w); }
            z[c] = wave_sum(d) * rstd; }
        float zc = z[0];
#pragma unroll
        for (int c = 1; c < 8; ++c) zc = lane == c ? z[c] : zc;
        const int b = m >> 12, tt = m & 4095;
        if (lane < 4) gate[(size_t)(b * 4 + lane) * SEQ + tt] = zc + A.in[16][lane];
        else if (lane < 8) gate[(size_t)(16 + b * 4 + lane - 4) * SEQ + tt] = log_sigmoid(zc + A.in[17][lane - 4]);
    }
    __syncthreads();
}

__device__ __forceinline__ void fox_unit(const Args& A, ldsp lds, LAS float* wscr, int bh, int qb) {
    unsigned char* ws = A.ws;
    const int b = bh >> 3, hd = bh & 7, tid_ = otid(), lane = tid_ & 63, wid = tid_ >> 6, n = lane & 31, h = lane >> 5;
    const bf16_t* P = (const bf16_t*)(ws + WS_R1);
    const size_t PS = (size_t)T * 512, ro = (size_t)b * SEQ * 512 + hd * 64;
    f32x16 o[2];
    flash_unit<64, 64, 1>(lds, wscr, P + ro, 512, P + PS + ro, 512, P + 2 * PS + ro, 512, (const float*)(ws + WS_GATE) + (size_t)bh * SEQ, qb * 256, qb * 4 + 4, o);
    bf16_t* mixed = (bf16_t*)(ws + WS_R2);
    const int qw = qb * 256 + 32 * wid;
#pragma unroll
    for (int db = 0; db < 2; ++db)
#pragma unroll
        for (int r = 0; r < 16; ++r) mixed[(size_t)(b * SEQ + qw + crow(r, h)) * D + hd * 64 + db * 32 + n] = f2bf(o[db][r]);
}
__device__ __forceinline__ void diff_unit(const Args& A, ldsp lds, LAS float* wscr, int bh, int qb) {
    unsigned char* ws = A.ws;
    const int b = bh >> 2, hd = bh & 3, tid_ = otid(), lane = tid_ & 63, wid = tid_ >> 6, n = lane & 31, h = lane >> 5;
    const bf16_t* P = (const bf16_t*)(ws + WS_R1);
    const size_t PS = (size_t)T * 512, ro = (size_t)b * SEQ * 512 + hd * 128;
    const float lam = ((const float*)(ws + WS_MISC))[0];
    f32x16 o[4];
    flash_unit<64, 128, 2>(lds, wscr, P + 3 * PS + ro, 512, P + 4 * PS + ro, 512, P + 5 * PS + ro, 512, nullptr, qb * 256, qb * 4 + 4, o);
    LAS unsigned* o1s = (LAS unsigned*)(lds + 60416 + wid * 8192) + lane;
#pragma unroll
    for (int db = 0; db < 4; ++db)
#pragma unroll
        for (int r = 0; r < 8; ++r) o1s[(db * 8 + r) * 64] = cvtpk(o[db][2 * r], o[db][2 * r + 1]);
    flash_unit<64, 128, 2>(lds, wscr, P + 3 * PS + ro + 64, 512, P + 4 * PS + ro + 64, 512, P + 5 * PS + ro, 512, nullptr, qb * 256, qb * 4 + 4, o);
    float ss[16];
#pragma unroll
    for (int r = 0; r < 16; ++r) ss[r] = 0.f;
#pragma unroll
    for (int db = 0; db < 4; ++db)
#pragma unroll
        for (int r = 0; r < 8; ++r) { const unsigned o1v = o1s[(db * 8 + r) * 64]; const float d0 = bflo(o1v) - lam * o[db][2 * r], d1 = bfhi(o1v) - lam * o[db][2 * r + 1]; o[db][2 * r] = d0; o[db][2 * r + 1] = d1; ss[2 * r] += d0 * d0; ss[2 * r + 1] += d1 * d1; }
#pragma unroll
    for (int r = 0; r < 16; ++r) {
#pragma unroll
        for (int x = 1; x < 32; x <<= 1) ss[r] += __shfl_xor(ss[r], x);
        ss[r] = rsqrtf(ss[r] * (1.0f / 128.0f) + EPS) * 0.8f; }
    bf16_t* mixed = (bf16_t*)(ws + WS_R2);
    const int qw = qb * 256 + 32 * wid;
#pragma unroll
    for (int db = 0; db < 4; ++db) { const float g = A.in[12][db * 32 + n];
#pragma unroll
        for (int r = 0; r < 16; ++r) mixed[(size_t)(b * SEQ + qw + crow(r, h)) * D + 512 + hd * 128 + db * 32 + n] = f2bf(o[db][r] * ss[r] * g); }
}
__device__ __forceinline__ void xattn_unit(const Args& A, ldsp lds, LAS float* wscr, int layer, int u) {
    unsigned char* ws = A.ws;
    const int dvh = u & 1, qb = (u >> 1) & 15, hd = (u >> 5) & 3, b = u >> 7, tid_ = otid(), lane = tid_ & 63, wid = tid_ >> 6, n = lane & 31, h = lane >> 5;
    const bf16_t* QX = (const bf16_t*)(ws + WS_R1) + (size_t)b * SEQ * D + hd * 256;
    const bf16_t* KV = (const bf16_t*)(ws + WS_KV) + (size_t)layer * MEMT * 2048 + (size_t)b * 256 * 2048 + hd * 256;
    f32x16 o[4];
    flash_unit<256, 128, 0>(lds, wscr, QX, D, KV, 2048, KV + 1024 + dvh * 128, 2048, nullptr, qb * 256, 4, o);
    bf16_t* xo = (bf16_t*)(ws + WS_R1 + 32 * MiB);
    const int qw = qb * 256 + 32 * wid;
#pragma unroll
    for (int db = 0; db < 4; ++db)
#pragma unroll
        for (int r = 0; r < 16; ++r) xo[(size_t)(b * SEQ + qw + crow(r, h)) * D + hd * 256 + dvh * 128 + db * 32 + n] = f2bf(o[db][r]);
}
__device__ __forceinline__ void xattn_unit2(const Args& A, ldsp lds, LAS float* wscr, int layer, int b, int hd, int qb) {
    constexpr int PK = 528, KBY = 64 * PK, PV = 320, VBY = 64 * PV;
    unsigned char* ws = A.ws;
    const int tid = otid(), lane = tid & 63, wid = tid >> 6, n = lane & 31, h = lane >> 5, i16 = lane & 15, q4 = i16 >> 2, p4 = i16 & 3, blk = (lane >> 4) & 1;
    const int qw = qb * 256 + 32 * wid;
    const bf16_t* Q = (const bf16_t*)(ws + WS_R1) + (size_t)b * SEQ * D + hd * 256;
    const bf16_t* Kp = (const bf16_t*)(ws + WS_KV) + (size_t)layer * MEMT * 2048 + (size_t)b * 256 * 2048 + hd * 256;
    const bf16_t* Vp = Kp + 1024;
    bf16x8 qf[16];
#pragma unroll
    for (int st = 0; st < 16; ++st) qf[st] = *(const bf16x8*)(Q + (size_t)(qw + n) * D + 16 * st + 8 * h);
    u32x4 kr[4];
#pragma unroll
    for (int i = 0; i < 4; ++i) { const int cid = tid + 512 * i, row = cid >> 5, cc = cid & 31; kr[i] = *(const u32x4*)(Kp + (size_t)row * 2048 + cc * 8); }
#pragma unroll
    for (int i = 0; i < 4; ++i) { const int cid = tid + 512 * i, row = cid >> 5, cc = cid & 31; *(LAS u32x4*)(lds + row * PK + cc * 16) = kr[i]; }
    __syncthreads();
    f32x16 S[8];
#pragma unroll
    for (int j = 0; j < 4; ++j) {
        ldsp st = lds + (j & 1) * KBY;
        if (j < 3) {
#pragma unroll
            for (int i = 0; i < 4; ++i) { const int cid = tid + 512 * i, row = cid >> 5, cc = cid & 31; kr[i] = *(const u32x4*)(Kp + (size_t)(64 * (j + 1) + row) * 2048 + cc * 8); }
        }
#pragma unroll
        for (int r = 0; r < 16; ++r) { S[2 * j][r] = 0.f; S[2 * j + 1][r] = 0.f; }
        ldsp ka = st + n * PK + 16 * h;
#pragma unroll
        for (int s = 0; s < 16; ++s) {
            const bf16x8 a0 = *(const LAS bf16x8*)(ka + 32 * s), a1 = *(const LAS bf16x8*)(ka + 32 * PK + 32 * s);
            S[2 * j] = MFMA32(a0, qf[s], S[2 * j]); S[2 * j + 1] = MFMA32(a1, qf[s], S[2 * j + 1]);
        }
        if (j < 3) {
#pragma unroll
            for (int i = 0; i < 4; ++i) { const int cid = tid + 512 * i, row = cid >> 5, cc = cid & 31; *(LAS u32x4*)(lds + ((j + 1) & 1) * KBY + row * PK + cc * 16) = kr[i]; }
        }
        __syncthreads();
    }
    u32x4 vr[2];
#pragma unroll
    for (int i = 0; i < 2; ++i) { const int cid = tid + 512 * i, row = cid >> 4, cc = cid & 15; vr[i] = *(const u32x4*)(Vp + (size_t)row * 2048 + cc * 8); }
    float mx = S[0][0];
#pragma unroll
    for (int t = 0; t < 8; ++t)
#pragma unroll
        for (int r = 0; r < 16; ++r) mx = fmaxf(mx, S[t][r]);
    mx = fmaxf(mx, __shfl_xor(mx, 32));
    f32x2 rs2 = {0.f, 0.f};
    bf16x8 P[8][2];
#pragma unroll
    for (int t = 0; t < 8; ++t) {
#pragma unroll
        for (int r = 0; r < 16; r += 2) { const f32x2 a = (f32x2){S[t][r], S[t][r + 1]} - mx; const f32x2 e = {ex2(a.x), ex2(a.y)}; S[t][r] = e.x; S[t][r + 1] = e.y; rs2 = rs2 + e; }
        P[t][0] = pack8(S[t], 0); P[t][1] = pack8(S[t], 1);
    }
    float lsum = rs2.x + rs2.y; lsum += __shfl_xor(lsum, 32);
    wscr[n] = 1.0f / lsum;
    asm volatile("s_waitcnt lgkmcnt(0)" ::: "memory");
    f32x4 linv[4];
#pragma unroll
    for (int g = 0; g < 4; ++g) linv[g] = *(const LAS f32x4*)(wscr + 8 * g + 4 * h);
#pragma unroll
    for (int i = 0; i < 2; ++i) { const int cid = tid + 512 * i, row = cid >> 4, cc = cid & 15; *(LAS u32x4*)(lds + row * PV + cc * 16) = vr[i]; }
    __syncthreads();
    bf16_t* xo = (bf16_t*)(ws + WS_R1 + 32 * MiB);
    f32x16 o[4];
#pragma unroll
    for (int t = 0; t < 8; ++t) {
        const int j = t & 3, dvh = t >> 2;
        ldsp st = lds + (t & 1) * VBY;
        if (t < 7) {
#pragma unroll
            for (int i = 0; i < 2; ++i) { const int cid = tid + 512 * i, row = cid >> 4, cc = cid & 15; vr[i] = *(const u32x4*)(Vp + (size_t)(64 * ((t + 1) & 3) + row) * 2048 + ((t + 1) >> 2) * 128 + cc * 8); }
        }
        if (j == 0) {
#pragma unroll
            for (int db = 0; db < 4; ++db)
#pragma unroll
                for (int r = 0; r < 16; ++r) o[db][r] = 0.f;
        }
        ldsp vb = st + (4 * h + q4) * PV + blk * 32 + 8 * p4;
#pragma unroll
        for (int ks = 0; ks < 4; ++ks) {
            const bf16x8 pa = P[2 * j + (ks >> 1)][ks & 1];
#pragma unroll
            for (int db = 0; db < 4; ++db) { const bf16x8 bv = tr8(vb + (16 * ks) * PV + db * 64, 8 * PV); o[db] = MFMA32(pa, bv, o[db]); }
        }
        if (j == 3) {
#pragma unroll
            for (int db = 0; db < 4; ++db)
#pragma unroll
                for (int r = 0; r < 16; ++r) xo[(size_t)(b * SEQ + qw + crow(r, h)) * D + hd * 256 + dvh * 128 + db * 32 + n] = f2bf(o[db][r] * linv[r >> 2][r & 3]);
        }
        if (t < 7) {
#pragma unroll
            for (int i = 0; i < 2; ++i) { const int cid = tid + 512 * i, row = cid >> 4, cc = cid & 15; *(LAS u32x4*)(lds + ((t + 1) & 1) * VBY + row * PV + cc * 16) = vr[i]; }
        }
        __syncthreads();
    }
}
__device__ __forceinline__ int next_unit(unsigned* ctr, LAS int* bc) {
    __syncthreads();
    if (threadIdx.x == 0) bc[0] = (int)atomicAdd(ctr, 1u);
    __syncthreads();
    return bc[0];
}

__device__ __forceinline__ void ffn_fixup(const Args& A, int layer, int gt, int ngt) {
    unsigned char* ws = A.ws;
    const float* head = (const float*)(ws + WS_R2); const float* tail = head + (size_t)512 * NUP;
    bf16_t* act = (bf16_t*)(ws + WS_R1);
    const float* cw = A.in[24] + (size_t)layer * 3 * NUP; const float* cb = A.in[25] + (size_t)layer * NUP;
    for (int it = gt; it < 256 * 2 * (DFF / 4); it += ngt) {
        const int j = (it % (DFF / 4)) * 4, rr = (it / (DFF / 4)) & 1, G = it / (DFF / 2);
        const bool first = (G & 63) == 0;
        f32x4 hv[2];
#pragma unroll
        for (int part = 0; part < 2; ++part) {
            const int c = part * DFF + j;
            const f32x4 z = {0.f, 0.f, 0.f, 0.f};
            const f32x4 pm2 = first ? z : *(const f32x4*)(tail + (size_t)((G - 1) * 2 + 0) * NUP + c), pm1 = first ? z : *(const f32x4*)(tail + (size_t)((G - 1) * 2 + 1) * NUP + c);
            const f32x4 p0 = *(const f32x4*)(head + (size_t)(G * 2 + 0) * NUP + c), p1 = *(const f32x4*)(head + (size_t)(G * 2 + 1) * NUP + c);
            const f32x4 w0 = *(const f32x4*)(cw + c), w1 = *(const f32x4*)(cw + NUP + c), w2 = *(const f32x4*)(cw + 2 * NUP + c), bb = *(const f32x4*)(cb + c);
            hv[part] = rr == 0 ? (w0 * pm2 + w1 * pm1 + w2 * p0 + bb) : (w0 * pm1 + w1 * p0 + w2 * p1 + bb);
        }
        u32x2 w; w.x = cvtpk(gelu_tanh(hv[0][0]) * hv[1][0], gelu_tanh(hv[0][1]) * hv[1][1]); w.y = cvtpk(gelu_tanh(hv[0][2]) * hv[1][2], gelu_tanh(hv[0][3]) * hv[1][3]);
        *(u32x2*)(act + (size_t)(G * 64 + rr) * DFF + j) = w;
    }
}

__device__ __forceinline__ void mlstm_conv(const Args& A, int gt, int ngt) {
    unsigned char* ws = A.ws;
    const bf16_t* src = (const bf16_t*)(ws + WS_R1); bf16_t* dst = (bf16_t*)A.out;
    const float* cw = A.in[15];
    for (int it = gt; it < 128 * 1024; it += ngt) {
        const int c0 = (it & 127) * 8, rb = it >> 7, row0 = rb * 16, t0 = row0 & 4095;
        float w[4][8];
#pragma unroll
        for (int tap = 0; tap < 4; ++tap) { const f32x4 a = *(const f32x4*)(cw + tap * 1024 + c0), b = *(const f32x4*)(cw + tap * 1024 + c0 + 4);
            w[tap][0] = a.x; w[tap][1] = a.y; w[tap][2] = a.z; w[tap][3] = a.w; w[tap][4] = b.x; w[tap][5] = b.y; w[tap][6] = b.z; w[tap][7] = b.w; }
        const float qs = c0 < 512 ? 0.08838834764831845f : 1.0f;
        u32x4 x3 = {0, 0, 0, 0}, x2 = x3, x1 = x3;
        if (t0 > 0) { x3 = *(const u32x4*)(src + (size_t)(row0 - 3) * D + c0); x2 = *(const u32x4*)(src + (size_t)(row0 - 2) * D + c0); x1 = *(const u32x4*)(src + (size_t)(row0 - 1) * D + c0); }
#pragma unroll 4
        for (int r = 0; r < 16; ++r) {
            const u32x4 x0 = *(const u32x4*)(src + (size_t)(row0 + r) * D + c0);
            float y[8];
#pragma unroll
            for (int e = 0; e < 4; ++e) {
                y[2 * e] = w[0][2 * e] * bflo(x3[e]) + w[1][2 * e] * bflo(x2[e]) + w[2][2 * e] * bflo(x1[e]) + w[3][2 * e] * bflo(x0[e]);
                y[2 * e + 1] = w[0][2 * e + 1] * bfhi(x3[e]) + w[1][2 * e + 1] * bfhi(x2[e]) + w[2][2 * e + 1] * bfhi(x1[e]) + w[3][2 * e + 1] * bfhi(x0[e]);
            }
#pragma unroll
            for (int e = 0; e < 8; ++e) y[e] = y[e] * __builtin_amdgcn_rcpf(1.f + __expf(-y[e])) * qs;
            u32x4 o; o.x = cvtpk(y[0], y[1]); o.y = cvtpk(y[2], y[3]); o.z = cvtpk(y[4], y[5]); o.w = cvtpk(y[6], y[7]);
            *(u32x4*)(dst + (size_t)(row0 + r) * D + c0) = o;
            x3 = x2; x2 = x1; x1 = x0;
        }
    }
}
constexpr int ML_PK = 320, ML_PV = 576, ML_PQ = 272;
__device__ __forceinline__ void mlstm_state_unit(const Args& A, ldsp lds, int u) {
    unsigned char* ws = A.ws;
    const int tid = otid(), lane = tid & 63, wid = tid >> 6, n = lane & 31, h = lane >> 5, i16 = lane & 15, q4 = i16 >> 2, p4 = i16 & 3, blk = (lane >> 4) & 1;
    const int bh = u >> 6, c = u & 63, b = bh >> 2, hd = bh & 3, r0 = b * SEQ + c * 64;
    const float* gate = (const float*)(ws + WS_GATE);
    float* chs = (float*)(ws + WS_CH);
    ldsp kt = lds, vt = lds + 64 * ML_PK; LAS float* wk = (LAS float*)(lds + 64 * ML_PK + 64 * ML_PV);
    const bf16_t* kq = (const bf16_t*)A.out + (size_t)r0 * D + 512 + hd * 128;
    const bf16_t* vp = (const bf16_t*)(ws + WS_R1 + 32 * MiB) + (size_t)r0 * D + hd * 256;
    u32x4 kx[2], vx[4];
#pragma unroll
    for (int i = 0; i < 2; ++i) { const int cid = tid + 512 * i, row = cid >> 4, cc = cid & 15; kx[i] = *(const u32x4*)(kq + (size_t)row * D + cc * 8); }
#pragma unroll
    for (int i = 0; i < 4; ++i) { const int cid = tid + 512 * i, row = cid >> 5, cc = cid & 31; vx[i] = *(const u32x4*)(vp + (size_t)row * D + cc * 8); }
    if (tid < 64) {
        const float ic = gate[(size_t)bh * SEQ + c * 64 + tid], fc = gate[(size_t)(16 + bh) * SEQ + c * 64 + tid];
        float bs = fc;
#pragma unroll
        for (int o = 1; o < 64; o <<= 1) { const float x = __shfl_up(bs, o); if (lane >= o) bs += x; }
        const float g = __shfl(bs, 63), a = g - bs + ic;
        float ml = a;
#pragma unroll
        for (int o = 1; o < 64; o <<= 1) ml = fmaxf(ml, __shfl_xor(ml, o));
        wk[tid] = __expf(a - ml);
        if (tid == 0) { chs[u] = g; chs[1024 + u] = ml; }
    }
    __syncthreads();
#pragma unroll
    for (int i = 0; i < 2; ++i) { const int cid = tid + 512 * i, row = cid >> 4, cc = cid & 15; const u32x4 x = kx[i]; const float w = wk[row];
        u32x4 y; y.x = cvtpk(bflo(x.x) * w, bfhi(x.x) * w); y.y = cvtpk(bflo(x.y) * w, bfhi(x.y) * w); y.z = cvtpk(bflo(x.z) * w, bfhi(x.z) * w); y.w = cvtpk(bflo(x.w) * w, bfhi(x.w) * w);
        *(LAS u32x4*)(kt + row * ML_PK + cc * 16) = y; }
#pragma unroll
    for (int i = 0; i < 4; ++i) { const int cid = tid + 512 * i, row = cid >> 5, cc = cid & 31; *(LAS u32x4*)(vt + row * ML_PV + cc * 16) = vx[i]; }
    __syncthreads();
    {
        const int d = tid & 127, qr = tid >> 7; float s = 0.f;
#pragma unroll
        for (int r = 0; r < 16; ++r) s += bf2f(*(const LAS bf16_t*)(kt + (16 * qr + r) * ML_PK + d * 2));
        wk[64 + tid] = s;
    }
    const int ib = wid & 3, vh = wid >> 2;
    f32x16 acc[4];
#pragma unroll
    for (int db = 0; db < 4; ++db)
#pragma unroll
        for (int r = 0; r < 16; ++r) acc[db][r] = 0.f;
#pragma unroll
    for (int st = 0; st < 4; ++st) {
        const bf16x8 af = tr8(kt + (16 * st + 8 * h + q4) * ML_PK + ib * 64 + blk * 32 + 8 * p4, 4 * ML_PK);
#pragma unroll
        for (int db = 0; db < 4; ++db) { const bf16x8 bv = tr8(vt + (16 * st + 8 * h + q4) * ML_PV + (vh * 4 + db) * 64 + blk * 32 + 8 * p4, 4 * ML_PV); acc[db] = MFMA32(af, bv, acc[db]); }
    }
    bf16_t* Sst = (bf16_t*)(ws + WS_R2) + (size_t)u * 128 * 256;
#pragma unroll
    for (int db = 0; db < 4; ++db)
#pragma unroll
        for (int r = 0; r < 16; ++r) Sst[(size_t)(ib * 32 + crow(r, h)) * 256 + (vh * 4 + db) * 32 + n] = f2bf(acc[db][r]);
    __syncthreads();
    if (tid < 128) ((float*)(ws + WS_NST))[(size_t)u * 128 + tid] = (wk[64 + tid] + wk[192 + tid]) + (wk[320 + tid] + wk[448 + tid]);
    __syncthreads();
}
__device__ __forceinline__ void mlstm_scan(const Args& A, int gt, int ngt) {
    unsigned char* ws = A.ws;
    float* chs = (float*)(ws + WS_CH);
    for (int it = gt; it < 16 * 8192 + 2048; it += ngt) {
        const bool isn = it >= 16 * 8192;
        const int bh = isn ? (it - 16 * 8192) >> 7 : it >> 13, e = isn ? (it - 16 * 8192) & 127 : (it & 8191) * 4;
        float m = 0.f; float c0 = 0.f, c1 = 0.f, c2 = 0.f, c3 = 0.f;
        for (int cb = 0; cb < 64; cb += 8) {
            u32x2 xv[8]; float xn[8], gg[8], mm[8];
#pragma unroll
            for (int i = 0; i < 8; ++i) { const int u = bh * 64 + cb + i; gg[i] = chs[u]; mm[i] = chs[1024 + u];
                if (isn) xn[i] = *((const float*)(ws + WS_NST) + (size_t)u * 128 + e); else xv[i] = *(const u32x2*)((const bf16_t*)(ws + WS_R2) + (size_t)u * 32768 + e); }
#pragma unroll
            for (int i = 0; i < 8; ++i) {
                const int u = bh * 64 + cb + i;
                const float g = gg[i], ml = mm[i], mnew = fmaxf(g + m, ml), dec = __expf(g + m - mnew), sc = __expf(ml - mnew);
                if (isn) { *((float*)(ws + WS_NST) + (size_t)u * 128 + e) = c0; c0 = dec * c0 + sc * xn[i]; }
                else { u32x2 y; y.x = cvtpk(c0, c1); y.y = cvtpk(c2, c3); *(u32x2*)((bf16_t*)(ws + WS_R2) + (size_t)u * 32768 + e) = y;
                    c0 = dec * c0 + sc * bflo(xv[i].x); c1 = dec * c1 + sc * bfhi(xv[i].x); c2 = dec * c2 + sc * bflo(xv[i].y); c3 = dec * c3 + sc * bfhi(xv[i].y);
                    if (e == 0) chs[2048 + u] = m; }
                m = mnew;
            }
        }
    }
}
__device__ __forceinline__ void mlstm_out_unit(const Args& A, ldsp lds, int u, bool dummy = false) {
    unsigned char* ws = A.ws;
    const int tid = otid(), lane = tid & 63, wid = tid >> 6, n = lane & 31, h = lane >> 5, i16 = lane & 15, q4 = i16 >> 2, p4 = i16 & 3, blk = (lane >> 4) & 1;
    const int bh = u >> 6, c = u & 63, b = bh >> 2, hd = bh & 3, r0 = b * SEQ + c * 64;
    const float* gate = (const float*)(ws + WS_GATE); const float* chs = (const float*)(ws + WS_CH);
    ldsp qt = lds, kt = lds + 64 * ML_PQ, vt = lds + 2 * 64 * ML_PQ, ct = vt + 64 * ML_PV;
    LAS float* sc = (LAS float*)(ct + 64 * ML_PV);
    LAS float *bt = sc, *ib = sc + 64, *mt = sc + 128, *wi = sc + 192, *qn = sc + 256, *rinv = sc + 320, *nv = sc + 384, *hs = sc + 512;
    const float mc = chs[2048 + u];
    if (tid < 64) {
        const float ic = gate[(size_t)bh * SEQ + c * 64 + tid], fc = gate[(size_t)(16 + bh) * SEQ + c * 64 + tid];
        float bs = fc;
#pragma unroll
        for (int o = 1; o < 64; o <<= 1) { const float x = __shfl_up(bs, o); if (lane >= o) bs += x; }
        const float ibv = ic - bs; float pm = ibv;
#pragma unroll
        for (int o = 1; o < 64; o <<= 1) { const float x = __shfl_up(pm, o); if (lane >= o) pm = fmaxf(pm, x); }
        const float mtv = fmaxf(bs + mc, bs + pm);
        bt[tid] = bs; ib[tid] = ibv; mt[tid] = mtv; wi[tid] = __expf(bs + mc - mtv);
    }
    const bf16_t* qp = (const bf16_t*)A.out + (size_t)r0 * D + hd * 128;
    bf16_t* vp = (bf16_t*)(ws + WS_R1 + 32 * MiB) + (size_t)r0 * D + hd * 256;
    const bf16_t* Cs = (const bf16_t*)(ws + WS_R2) + (size_t)u * 32768;
#pragma unroll
    for (int i = 0; i < 2; ++i) { const int cid = tid + 512 * i, row = cid >> 4, cc = cid & 15;
        *(LAS u32x4*)(qt + row * ML_PQ + cc * 16) = *(const u32x4*)(qp + (size_t)row * D + cc * 8);
        *(LAS u32x4*)(kt + row * ML_PQ + cc * 16) = *(const u32x4*)(qp + (size_t)row * D + 512 + cc * 8); }
    u32x4 c2r[4];
#pragma unroll
    for (int i = 0; i < 4; ++i) { const int cid = tid + 512 * i, row = cid >> 5, cc = cid & 31;
        *(LAS u32x4*)(vt + row * ML_PV + cc * 16) = *(const u32x4*)(vp + (size_t)row * D + cc * 8);
        *(LAS u32x4*)(ct + row * ML_PV + cc * 16) = *(const u32x4*)(Cs + (size_t)row * 256 + cc * 8);
        c2r[i] = *(const u32x4*)(Cs + (size_t)(64 + row) * 256 + cc * 8); }
    if (tid < 128) nv[tid] = ((const float*)(ws + WS_NST))[(size_t)u * 128 + tid];
    const int tb = wid & 1, eq = wid >> 1, t = 32 * tb + n;
    const bf16_t* og = (const bf16_t*)(ws + WS_R1 + 64 * MiB);
    const float* hn = A.in[18];
    bf16_t ogr[16][2]; float hnr[2];
#pragma unroll
    for (int eb = 0; eb < 2; ++eb) { const int col = hd * 256 + eq * 64 + eb * 32 + n; hnr[eb] = hn[col];
#pragma unroll
        for (int r = 0; r < 16; ++r) ogr[r][eb] = og[(size_t)(r0 + 32 * tb + crow(r, h)) * D + col]; }
    __syncthreads();
    {
        const int tq = tid >> 3, part = tid & 7;
        const u32x4 qa = *(const LAS u32x4*)(qt + tq * ML_PQ + part * 32), qb2 = *(const LAS u32x4*)(qt + tq * ML_PQ + part * 32 + 16);
        const LAS f32x4* nv4 = (const LAS f32x4*)(nv + part * 16);
        const f32x4 n0 = nv4[0], n1 = nv4[1], n2 = nv4[2], n3 = nv4[3];
        float s = bflo(qa.x) * n0.x + bfhi(qa.x) * n0.y + bflo(qa.y) * n0.z + bfhi(qa.y) * n0.w + bflo(qa.z) * n1.x + bfhi(qa.z) * n1.y + bflo(qa.w) * n1.z + bfhi(qa.w) * n1.w
                + bflo(qb2.x) * n2.x + bfhi(qb2.x) * n2.y + bflo(qb2.y) * n2.z + bfhi(qb2.y) * n2.w + bflo(qb2.z) * n3.x + bfhi(qb2.z) * n3.y + bflo(qb2.w) * n3.z + bfhi(qb2.w) * n3.w;
        s += __shfl_xor(s, 1); s += __shfl_xor(s, 2); s += __shfl_xor(s, 4);
        if (part == 0) qn[tq] = s;
    }
    f32x16 p[2];
#pragma unroll
    for (int sh = 0; sh < 2; ++sh) {
#pragma unroll
        for (int r = 0; r < 16; ++r) p[sh][r] = 0.f;
#pragma unroll
        for (int st = 0; st < 8; ++st) {
            const bf16x8 a = *(const LAS bf16x8*)(kt + (32 * sh + n) * ML_PQ + (16 * st + 8 * h) * 2), bq = *(const LAS bf16x8*)(qt + t * ML_PQ + (16 * st + 8 * h) * 2);
            p[sh] = MFMA32(a, bq, p[sh]);
        }
    }
    const float btl = bt[t], mtl = mt[t];
    float dsum = 0.f;
#pragma unroll
    for (int sh = 0; sh < 2; ++sh)
#pragma unroll
        for (int g = 0; g < 4; ++g) { const f32x4 iv = *(const LAS f32x4*)(ib + 32 * sh + 8 * g + 4 * h);
#pragma unroll
            for (int e = 0; e < 4; ++e) { const int s = 32 * sh + 8 * g + 4 * h + e; const float w = s <= t ? ex2((btl - mtl + iv[e]) * LOG2E) : 0.f; const float v = p[sh][4 * g + e] * w; p[sh][4 * g + e] = v; dsum += v; } }
    dsum += __shfl_xor(dsum, 32);
    __syncthreads();
    if (eq == 0 && h == 0) { const float den = wi[t] * qn[t] + dsum; rinv[t] = 1.0f / fmaxf(fabsf(den), __expf(-mtl)); }
    f32x16 acc[2];
#pragma unroll
    for (int eb = 0; eb < 2; ++eb)
#pragma unroll
        for (int r = 0; r < 16; ++r) acc[eb][r] = 0.f;
#pragma unroll
    for (int hc = 0; hc < 2; ++hc) {
        if (hc == 1) {
            __syncthreads();
#pragma unroll
            for (int i = 0; i < 4; ++i) { const int cid = tid + 512 * i, row = cid >> 5, cc = cid & 31; *(LAS u32x4*)(ct + row * ML_PV + cc * 16) = c2r[i]; }
            __syncthreads();
        }
#pragma unroll
        for (int st = 0; st < 4; ++st) {
            const bf16x8 a = *(const LAS bf16x8*)(qt + t * ML_PQ + (64 * hc + 16 * st + 8 * h) * 2);
#pragma unroll
            for (int eb = 0; eb < 2; ++eb) { const bf16x8 bv = tr8(ct + (16 * st + 8 * h + q4) * ML_PV + (eq * 2 + eb) * 64 + blk * 32 + 8 * p4, 4 * ML_PV); acc[eb] = MFMA32(a, bv, acc[eb]); }
        }
    }
#pragma unroll
    for (int g = 0; g < 4; ++g) { const f32x4 w4 = *(const LAS f32x4*)(wi + 32 * tb + 8 * g + 4 * h);
#pragma unroll
        for (int eb = 0; eb < 2; ++eb)
#pragma unroll
            for (int e = 0; e < 4; ++e) acc[eb][4 * g + e] *= w4[e]; }
#pragma unroll
    for (int ks = 0; ks < 4; ++ks) {
        const bf16x8 pa = (ks & 2) ? pack8(p[1], ks & 1) : pack8(p[0], ks & 1);
#pragma unroll
        for (int eb = 0; eb < 2; ++eb) { const bf16x8 bv = tr8(vt + (16 * ks + 4 * h + q4) * ML_PV + (eq * 2 + eb) * 64 + blk * 32 + 8 * p4, 8 * ML_PV); acc[eb] = MFMA32(pa, bv, acc[eb]); }
    }
    float ss[16];
#pragma unroll
    for (int g = 0; g < 4; ++g) { const f32x4 r4 = *(const LAS f32x4*)(rinv + 32 * tb + 8 * g + 4 * h);
#pragma unroll
        for (int e = 0; e < 4; ++e) { const int r = 4 * g + e; acc[0][r] *= r4[e]; acc[1][r] *= r4[e]; ss[r] = acc[0][r] * acc[0][r] + acc[1][r] * acc[1][r]; } }
#pragma unroll
    for (int r = 0; r < 16; ++r) {
#pragma unroll
        for (int x = 1; x < 32; x <<= 1) ss[r] += __shfl_xor(ss[r], x);
        if (n == 0) hs[(tb * 4 + eq) * 32 + crow(r, h)] = ss[r]; }
    __syncthreads();
#pragma unroll
    for (int r = 0; r < 16; ++r) {
        const int tr = crow(r, h);
        const float tot = hs[(tb * 4 + 0) * 32 + tr] + hs[(tb * 4 + 1) * 32 + tr] + hs[(tb * 4 + 2) * 32 + tr] + hs[(tb * 4 + 3) * 32 + tr];
        const float rstd = rsqrtf(tot * (1.0f / 256.0f) + EPS);
#pragma unroll
        for (int eb = 0; eb < 2; ++eb) {
            const int col = hd * 256 + eq * 64 + eb * 32 + n; const size_t off = (size_t)(r0 + 32 * tb + tr) * D + col;
            const float ogv = bf2f(ogr[r][eb]);
            (dummy ? (bf16_t*)(ws + 240 * MiB) + (off & 0x7fffff) : (bf16_t*)(ws + WS_R1 + 32 * MiB) + off)[0] = f2bf(acc[eb][r] * rstd * hnr[eb] * __builtin_amdgcn_rcpf(1.f + __expf(-ogv)));
        }
    }
    __syncthreads();
}

#ifndef PR_WQ
#define PR_WQ 0
#endif
#ifndef PR_RC
#define PR_RC 0
#endif
#ifndef PR_MOUT
#define PR_MOUT 0
#endif
#ifndef PR_SYNC
#define PR_SYNC 0
#endif
#ifndef PR_ATT
#define PR_ATT 0
#endif
#ifndef PR_XATT
#define PR_XATT 0
#endif
#ifndef PR_P0
#define PR_P0 0
#endif
#ifndef PR_MST
#define PR_MST 0
#endif
#ifndef PR_INP
#define PR_INP 0
#endif
#ifndef PR_UP
#define PR_UP 0
#endif
#ifndef PR_CONV
#define PR_CONV 0
#endif
__device__ __forceinline__ int static_unit(int nM, int nN, int G, int c, int i) {
    const int nwg = nM * nN; const long L = (long)i * G + c; if (L >= nwg) return -1;
    int wgid = (int)L; { const int q = nwg / 8, r = nwg % 8, xcd = wgid % 8, off = wgid / 8; wgid = (xcd < r ? xcd * (q + 1) : r * (q + 1) + (xcd - r) * q) + off; }
    const int nig = 8 * nN, gid = wgid / nig, fm = gid * 8, gsz = (nM - fm) < 8 ? (nM - fm) : 8;
    return ((fm + ((wgid % nig) % gsz)) << 8) | ((wgid % nig) / gsz);
}
struct OneUnit { int pm, pn;
    __device__ __forceinline__ bool next(int i, pg8::Unit& u) const { if (i) return false; u.pm = pm; u.pn = pn; return true; }
    __device__ __forceinline__ void a_ready(const pg8::Unit&) const {}
    __device__ __forceinline__ void done(const pg8::Unit&) const {} };
#define GEMM_CALL(EPI, g, S, E) pg8::gemm_phase<EPI, pg8::StaticOrder, true, true>(lds, g, S, E)
__global__ void __launch_bounds__(512, 2) mega_fwd(Args A) {
    extern __shared__ __attribute__((aligned(16))) unsigned char lds_raw[];
    ldsp lds = (ldsp)lds_raw;
    cg::grid_group grid = cg::this_grid();
    const int G = gridDim.x, bx = blockIdx.x, vcu = (G % 8 == 0) ? (bx % 8) * (G / 8) + bx / 8 : bx;
    const int ngw = G * 8, ngt = G * 512;
    unsigned char* ws = A.ws;
#define tid otid()
#define lane (otid() & 63)
#define wid __builtin_amdgcn_readfirstlane(otid() >> 6)
#define gw (vcu * 8 + __builtin_amdgcn_readfirstlane(otid() >> 6))
#define gt (bx * 512 + otid())
#define wscr ((LAS float*)(lds + LDS_X) + __builtin_amdgcn_readfirstlane(otid() >> 6) * 64)
    LAS int* bc = (LAS int*)(lds + LDS_X + 4096);
    unsigned* ctr = (unsigned*)(ws + WS_CTL);
    volatile LAS unsigned* xbst = (volatile LAS unsigned*)(lds + LDS_X + 12288);
    if (threadIdx.x < 4) xbst[threadIdx.x] = 0u;
    __syncthreads();
    const XcdBarrier xbar = xcd_barrier_post((unsigned*)(ws + WS_CTL + 4096), xbst);
#define GSYNC() xcd_barrier(xbar)
    bf16_t* xb = (bf16_t*)(ws + WS_XB); float* ssq = (float*)(ws + WS_SSQ);

    for (int rep = 0; rep <= PR_P0; ++rep) {
    for (int it = gw; it < WT_ITEMS; it += ngw) wt_dispatch(A, it, lds + wid * 8448, lane);
    __syncthreads();
    row_pass<0>(A, lds, A.in[0], A.in[6], 1536, A.in[2], gw, ngw, tid, lane);
    }
    for (int m = gw; m < MEMT; m += ngw) {
        const f32x4* xr = (const f32x4*)(A.in[1] + (size_t)m * D) + lane; f32x4 v[4]; float s = 0.f;
#pragma unroll
        for (int j = 0; j < 4; ++j) { v[j] = xr[64 * j]; s += (v[j].x * v[j].x + v[j].y * v[j].y) + (v[j].z * v[j].z + v[j].w * v[j].w); }
        s = wave_sum(s);
        u32x2* o8 = (u32x2*)((bf16_t*)(ws + WS_MEMB) + (size_t)m * D) + lane;
#pragma unroll
        for (int j = 0; j < 4; ++j) { u32x2 w; w.x = cvtpk(v[j].x, v[j].y); w.y = cvtpk(v[j].z, v[j].w); o8[64 * j] = w; }
        if (lane < 16) ((float*)(ws + WS_SSQM))[(size_t)m * 16 + lane] = lane == 0 ? s : 0.f;
    }
    for (int it = gt; it < DFF; it += ngt) {
        const int l = it / (DFF / 2), j = (it % (DFF / 2)) * 2; const float* cw = A.in[24] + (size_t)l * 3 * NUP; const float* cb = A.in[25] + (size_t)l * NUP;
        f32x4* o = (f32x4*)((float*)(ws + WS_CWP) + (size_t)it * 16);
        o[0] = (f32x4){cw[j], cw[j + 1], cw[NUP + j], cw[NUP + j + 1]}; o[1] = (f32x4){cw[2 * NUP + j], cw[2 * NUP + j + 1], cb[j], cb[j + 1]};
        o[2] = (f32x4){cw[DFF + j], cw[DFF + j + 1], cw[NUP + DFF + j], cw[NUP + DFF + j + 1]}; o[3] = (f32x4){cw[2 * NUP + DFF + j], cw[2 * NUP + DFF + j + 1], cb[DFF + j], cb[DFF + j + 1]};
    }
    if (bx == 0 && wid == 0) {
        const float s1 = wave_sum(A.in[8][lane] * A.in[9][lane]), s2 = wave_sum(A.in[10][lane] * A.in[11][lane]);
        if (lane == 0) ((float*)(ws + WS_MISC))[0] = __expf(s1) - __expf(s2) + 0.2f;
    }
    if (G == 0x7fffffff) grid.sync();
    GSYNC();
    for (int rep = 0; rep < PR_SYNC; ++rep) GSYNC();

#pragma clang loop unroll(disable)
    for (int layer = 0; layer < 2; ++layer) {
        if (layer == 0 && bx < 32) seq_cumsum((float*)(ws + WS_GATE) + (size_t)bx * SEQ, LOG2E, (LAS float*)(lds + LDS_X + 8192), tid, lane, wid);
        {
            pg8::Gemm g{xb, (const bf16_t*)(ws + (layer == 0 ? WS_WIN0 : WS_WIN1)), T, 3072, 1024}; pg8::StaticOrder S; S.init(T, 3072, G, bx);
            EpiScaledT E{(bf16_t*)(ws + WS_R1), layer == 0 ? 512 : 1024, layer == 0 ? (size_t)T * 512 : (size_t)T * 1024, layer == 0 ? 512 : 1024, (const LAS float*)(lds + LDS_RSTAB), 0.125f * LOG2E, layer == 0 ? 9u : 0u};
            rstab_fill(lds, S, ssq);
#pragma clang loop unroll(disable)
            for (int rep = 0; rep <= PR_INP; ++rep) { E.ord = 0; GEMM_CALL(EpiScaledT, g, S, E); }
        }
        GSYNC();
        if (layer == 0) {
#pragma clang loop unroll(disable)
            for (int rep = 0; rep <= PR_ATT; ++rep)
            for (;;) {
                const int uq = next_unit(ctr + 8 * rep, bc); if (uq >= 768 + 64) break;
                if (uq < 64) {
                    const int l = uq >> 5;
                    pg8::Gemm g{(const bf16_t*)(ws + WS_MEMB), (const bf16_t*)(ws + WS_WKV) + (size_t)l * 2048 * 1024, MEMT, 2048, 1024}; OneUnit S{(uq >> 3) & 3, uq & 7};
                    EpiScaled E{(bf16_t*)(ws + WS_KV) + (size_t)l * MEMT * 2048, 2048, 0, 2048, (const float*)(ws + WS_SSQM), 1.f, 0u};
                    pg8::gemm_phase<EpiScaled, OneUnit, false, true>(lds, g, S, E);
                    continue;
                }
                const int u = uq - 64;
                const int qb = 15 - u / 48, r = u % 48;
                if (r < 16) diff_unit(A, lds, wscr, r, qb); else fox_unit(A, lds, wscr, r - 16, qb);
            }
            GSYNC();
        } else {
            for (int rep = 0; rep <= PR_RC; ++rep) {
            row_gates_b(A, lds, xb, A.in[14], 2048, A.in[2] + 1024, gw, ngw, tid, lane);
            mlstm_conv(A, gt, ngt);
            }
            GSYNC();
#pragma clang loop unroll(disable)
            for (int rep = 0; rep <= PR_MST; ++rep)
            for (int u = bx; u < 1024; u += G) mlstm_state_unit(A, lds, u);
            GSYNC();
            mlstm_scan(A, gt, ngt);
            GSYNC();
            for (int rep = 0; rep < PR_MOUT; ++rep) for (int u = bx; u < 1024; u += G) mlstm_out_unit(A, lds, u, true);
            for (int u = bx; u < 1024; u += G) mlstm_out_unit(A, lds, u);
            GSYNC();
        }
        {
            pg8::Gemm g{(const bf16_t*)(ws + (layer == 0 ? WS_R2 : WS_R1 + 32 * MiB)), (const bf16_t*)(ws + (layer == 0 ? WS_WOUT0 : WS_WOUT1)), T, 1024, 1024}; pg8::StaticOrder S; S.init(T, 1024, G, bx);
            EpiRes E{layer == 0 ? A.in[0] : (const float*)nullptr, xb, ssq};
            GEMM_CALL(EpiRes, g, S, E);
        }
        GSYNC();
        {
            pg8::Gemm g{xb, (const bf16_t*)(ws + WS_WQ) + (size_t)layer * 1024 * 1024, T, 1024, 1024}; pg8::StaticOrder S; S.init(T, 1024, G, bx);
            EpiScaled E{(bf16_t*)(ws + WS_R1), 1024, 0, 1024, ssq, 0.0625f * LOG2E, 1u};
#pragma clang loop unroll(disable)
            for (int rep = 0; rep <= PR_WQ; ++rep) GEMM_CALL(EpiScaled, g, S, E);
            asm volatile("s_waitcnt vmcnt(0)" ::: "memory"); __syncthreads();
#pragma clang loop unroll(disable)
            for (int i = 0;; ++i) {
                const int uc = static_unit(T / 256, 4, G, bx, i); if (uc < 0) break;
                const int qpm = uc >> 8, qpn = uc & 255;
#pragma clang loop unroll(disable)
                for (int once = 0; once < 1; ++once) xattn_unit2(A, lds, wscr, layer, qpm >> 4, qpn, qpm & 15);
            }
        }
        GSYNC();
        {
            pg8::Gemm g{(const bf16_t*)(ws + WS_R1 + 32 * MiB), (const bf16_t*)(ws + WS_WO) + (size_t)layer * 1024 * 1024, T, 1024, 1024}; pg8::StaticOrder S; S.init(T, 1024, G, bx);
            EpiRes E{nullptr, xb, ssq};
            GEMM_CALL(EpiRes, g, S, E);
        }
        GSYNC();
        {
            pg8::Gemm g{xb, (const bf16_t*)(ws + WS_WUP) + (size_t)layer * NUP * 1024, T, NUP, 1024}; pg8::StaticOrder S; S.init(T, NUP, G, bx);
            EpiUp E{(bf16_t*)(ws + WS_R1), (float*)(ws + WS_R2), (float*)(ws + WS_R2) + (size_t)512 * NUP, ssq, (const float*)(ws + WS_CWP) + (size_t)layer * DFF * 8, (const LAS float*)(lds + LDS_RSTAB), (LAS float*)(lds + LDS_CWPS)};
            rstab_fill(lds, S, ssq);
#pragma clang loop unroll(disable)
            for (int rep = 0; rep <= PR_UP; ++rep) { E.ord = 0; GEMM_CALL(EpiUp, g, S, E); }
        }
        GSYNC();
        ffn_fixup(A, layer, gt, ngt);
        GSYNC();
        {
            pg8::Gemm g{(const bf16_t*)(ws + WS_R1), (const bf16_t*)(ws + WS_WDN) + (size_t)layer * 1024 * DFF, T, 1024, DFF}; pg8::StaticOrder S; S.init(T, 1024, G, bx);
            EpiRes E{nullptr, xb, ssq};
            GEMM_CALL(EpiRes, g, S, E);
        }
        GSYNC();
    }
    {
        u32x4 fnx[2];
        if (gw < T) { fnx[0] = ((const u32x4*)(xb + (size_t)gw * D))[lane]; fnx[1] = ((const u32x4*)(xb + (size_t)gw * D))[64 + lane]; }
        for (int m = gw; m < T; m += ngw) {
            float vv[2][8]; float s = 0.f;
#pragma unroll
            for (int j = 0; j < 2; ++j) { const u32x4 r = fnx[j];
                vv[j][0] = bflo(r.x); vv[j][1] = bfhi(r.x); vv[j][2] = bflo(r.y); vv[j][3] = bfhi(r.y); vv[j][4] = bflo(r.z); vv[j][5] = bfhi(r.z); vv[j][6] = bflo(r.w); vv[j][7] = bfhi(r.w);
#pragma unroll
                for (int e = 0; e < 8; ++e) s += vv[j][e] * vv[j][e]; }
            if (m + ngw < T) { fnx[0] = ((const u32x4*)(xb + (size_t)(m + ngw) * D))[lane]; fnx[1] = ((const u32x4*)(xb + (size_t)(m + ngw) * D))[64 + lane]; }
            const float rstd = rsqrtf(wave_sum(s) * (1.0f / 1024.0f) + EPS);
#pragma unroll
            for (int j = 0; j < 2; ++j) { const f32x4 g0 = *(const f32x4*)(A.in[27] + 512 * j + 8 * lane), g1 = *(const f32x4*)(A.in[27] + 512 * j + 8 * lane + 4);
                f32x4* o = (f32x4*)(A.out + (size_t)m * D + 512 * j + 8 * lane);
                o[0] = (f32x4){vv[j][0], vv[j][1], vv[j][2], vv[j][3]} * rstd * g0; o[1] = (f32x4){vv[j][4], vv[j][5], vv[j][6], vv[j][7]} * rstd * g1; }
        }
    }
#undef tid
#undef lane
#undef wid
#undef gw
#undef gt
#undef wscr
}

extern "C" void kernel_launch(void* const* d_in, const int* in_sizes, int n_in, void* d_out, int out_size, void* d_ws, size_t ws_size, hipStream_t stream) {
    static int grid = 0;
    if (grid == 0) {
        if (n_in != 28 || out_size != T * D || ws_size < WS_END) { fprintf(stderr, "kernel_launch: unexpected problem shape (n_in %d out %d ws %zu)\n", n_in, out_size, ws_size); grid = -1; return; }
        int dev = 0, cus = 0, per_cu = 0;
        if (hipGetDevice(&dev) != hipSuccess || hipDeviceGetAttribute(&cus, hipDeviceAttributeMultiprocessorCount, dev) != hipSuccess) { grid = -1; return; }
        if (hipFuncSetAttribute((const void*)mega_fwd, hipFuncAttributeMaxDynamicSharedMemorySize, LDS_BYTES) != hipSuccess) { fprintf(stderr, "kernel_launch: hipFuncSetAttribute failed\n"); grid = -1; return; }
        if (hipOccupancyMaxActiveBlocksPerMultiprocessor(&per_cu, (const void*)mega_fwd, 512, LDS_BYTES) != hipSuccess || per_cu < 1) { fprintf(stderr, "kernel_launch: occupancy query says %d blocks per CU\n", per_cu); (void)hipGetLastError(); per_cu = 1; }
        grid = cus;
        if (grid < 256) { fprintf(stderr, "kernel_launch: built for >= 256 CUs (got %d)\n", cus); grid = -1; return; }
    }
    if (grid < 0) return;
    (void)hipMemsetAsync((char*)d_ws + WS_CTL, 0, 32768, stream);
    Args a{};
    for (int i = 0; i < 28; ++i) a.in[i] = (const float*)d_in[i];
    a.out = (float*)d_out; a.ws = (unsigned char*)d_ws;
    void* args[] = {&a};
    hipError_t e = hipLaunchCooperativeKernel((const void*)mega_fwd, dim3(grid), dim3(512), args, LDS_BYTES, stream);
    if (e != hipSuccess) fprintf(stderr, "cooperative launch failed: %s (grid %d)\n", hipGetErrorString(e), grid);
}
```

```cpp
#include <hip/hip_runtime.h>
#include <hip/hip_cooperative_groups.h>
#include <cstdio>
#include <cstdint>
#include <cmath>
namespace cg = cooperative_groups;

namespace pg8 {
#define PG8_LAS __attribute__((address_space(3)))
typedef unsigned short bf16_t;
typedef short bf16x8 __attribute__((ext_vector_type(8)));
typedef float f32x4 __attribute__((ext_vector_type(4)));
typedef unsigned u32x4 __attribute__((ext_vector_type(4)));
constexpr int BM = 256, BK = 64, HALF = 128, HTB = HALF * BK * 2  , STAGE_BYTES = 8 * HTB, NXCD = 8, WGM = 8;

__host__ __device__ __forceinline__ int lds_byte(int r, int c) { const int st = (r >> 4) * 2 + (c >> 5), rr = r & 15, cc = c & 31, ob = rr * 64 + cc * 2; return st * 1024 + (ob ^ (((ob >> 9) & 1) << 5)); }
__host__ __device__ __forceinline__ void stage_rc(int b, int& R, int& C) { const int st = b / 1024, sb = b % 1024, swz = sb ^ (((sb >> 9) & 1) << 5); R = (st >> 1) * 16 + swz / 64; C = (st & 1) * 32 + (swz % 64) / 2; }
__host__ __device__ __forceinline__ int perm32(int rho) { const int n = rho >> 4, i = rho & 15; return 8 * (i >> 2) + 4 * n + (i & 3); }

struct Unit { int pm, pn; };
struct Gemm { const bf16_t* A; const bf16_t* Bt; int M, N, K; };

struct StaticOrder {
    int nM, nN, nwg, G, c;
    __host__ __device__ void init(int M, int N, int G_, int c_) { nM = M / BM; nN = N / BM; nwg = nM * nN; G = G_; c = c_; }
    __host__ __device__ bool next(int i, Unit& u) const {
        const long L = (long)i * G + c; if (L >= nwg) return false;
        int wgid = (int)L; { const int q = nwg / NXCD, r = nwg % NXCD, xcd = wgid % NXCD, off = wgid / NXCD; wgid = (xcd < r ? xcd * (q + 1) : r * (q + 1) + (xcd - r) * q) + off; }
        const int nig = WGM * nN, gid = wgid / nig, fm = gid * WGM, gsz = (nM - fm) < WGM ? (nM - fm) : WGM;
        u.pm = fm + ((wgid % nig) % gsz); u.pn = (wgid % nig) / gsz; return true;
    }
    __device__ __forceinline__ void a_ready(const Unit&) const {}
    __device__ __forceinline__ void done(const Unit&) const {}
};

__device__ __forceinline__ unsigned cvt_pk_bf16(float lo, float hi) { unsigned r; asm volatile("v_cvt_pk_bf16_f32 %0, %1, %2" : "=v"(r) : "v"(lo), "v"(hi)); return r; }
typedef float f32x2 __attribute__((ext_vector_type(2)));
__device__ __forceinline__ f32x2 gelu_pk(f32x2 v) {
    const f32x2 av = __builtin_elementwise_abs(v), d = av * 0.2316418882f + 1.0f;
    f32x2 t; t.x = __builtin_amdgcn_rcpf(d.x); t.y = __builtin_amdgcn_rcpf(d.y);
    f32x2 q = t * 0.5307027145f + (-0.7265760135f); q = q * t + 0.7107068705f; q = q * t + (-0.142248368f); q = q * t + 0.127414796f; q = q * t;
    const f32x2 s = (v * v) * (-0.72134752044f);
    f32x2 e; e.x = __builtin_amdgcn_exp2f(s.x); e.y = __builtin_amdgcn_exp2f(s.y);
    const f32x2 m = v * (q * e), r = v - m;
    f32x2 o; o.x = v.x < 0.f ? m.x : r.x; o.y = v.y < 0.f ? m.y : r.y; return o;
}

template <int ACT  > struct EpiBf16 {
    static constexpr bool PERM = true, AFTER_DRAIN = false; static_assert(ACT == 0 || ACT == 1, "EpiBf16: ACT is 0 (none) or 1 (gelu_pk)");
    bf16_t* O; int ldc; const float* bias; int split_cols; size_t split_stride; float scale0;
    __device__ __forceinline__ void operator()(const f32x4 (&acc)[2][2][4][2], const Unit& u, int wr, int wc, int fr, int fq) const {
        const int row0 = u.pm * BM + wr * 64 + fr; int colt = u.pn * BM; bf16_t* base = O;
        float sc = 1.f; if (split_cols) { const int t = colt / split_cols; base += (size_t)t * split_stride; colt -= t * split_cols; if (t == 0) sc = scale0; }
        const int col0 = colt + wc * 32 + 8 * fq, bcol0 = u.pn * BM + wc * 32 + 8 * fq;
        f32x4 bv[2][2];
#pragma unroll
        for (int bj = 0; bj < 2; ++bj)
#pragma unroll
            for (int n = 0; n < 2; ++n) bv[bj][n] = bias ? *(const f32x4*)(bias + bcol0 + bj * HALF + 4 * n) : (f32x4){0.f, 0.f, 0.f, 0.f};
#pragma unroll
        for (int ai = 0; ai < 2; ++ai)
#pragma unroll
            for (int m = 0; m < 4; ++m) { bf16_t* rowp = base + (size_t)(row0 + ai * HALF + m * 16) * ldc + col0;
#pragma unroll
                for (int bj = 0; bj < 2; ++bj) { f32x4 v0 = acc[ai][bj][m][0] + bv[bj][0], v1 = acc[ai][bj][m][1] + bv[bj][1];
                    if (ACT == 1) { f32x2 a = gelu_pk((f32x2){v0[0], v0[1]}), b = gelu_pk((f32x2){v0[2], v0[3]}), c = gelu_pk((f32x2){v1[0], v1[1]}), d = gelu_pk((f32x2){v1[2], v1[3]});
                        v0 = (f32x4){a.x, a.y, b.x, b.y}; v1 = (f32x4){c.x, c.y, d.x, d.y}; }
                    v0 = v0 * sc; v1 = v1 * sc; u32x4 w; w.x = cvt_pk_bf16(v0[0], v0[1]); w.y = cvt_pk_bf16(v0[2], v0[3]); w.z = cvt_pk_bf16(v1[0], v1[1]); w.w = cvt_pk_bf16(v1[2], v1[3]);
                    *(u32x4*)(rowp + bj * HALF) = w; } }
    }
};
template <class Epi> constexpr auto epi_aperm(int) -> decltype(Epi::APERM) { return Epi::APERM; }
template <class Epi> constexpr bool epi_aperm(long) { return false; }
template <class Epi, class Sched, bool ALIGN_EPI = false, bool SP2 = false>
__device__ __forceinline__ void gemm_phase(PG8_LAS unsigned char* lds, const Gemm g, const Sched& S, const Epi& E) {
    int tid_ = threadIdx.x; asm volatile("" : "+v"(tid_));
    const int tid = tid_, wid = __builtin_amdgcn_readfirstlane(tid >> 6), lane = tid & 63, wr = wid >> 2, wc = wid & 3, fr = lane & 15, fq = lane >> 4;
    const int K = g.K, nt = K / BK;
    unsigned voffA[2], voffB[2];
#pragma unroll
    for (int i = 0; i < 2; ++i) { int R, C; stage_rc(tid * 16 + i * 8192, R, C); const int Rb = Epi::PERM ? ((R & ~31) + perm32(R & 31)) : R;
        const int Ra = epi_aperm<Epi>(0) ? ((R & ~63) + 4 * (R & 15) + ((R >> 4) & 3)) : R;
        voffA[i] = (unsigned)(Ra * K + C) * 2u; voffB[i] = (unsigned)(Rb * K + C) * 2u; }
    const size_t kstep = (size_t)(BK * 2);
    const size_t hstep = (size_t)HALF * K * 2;
    const size_t tstep = 2 * hstep;
    const unsigned ldsw = (unsigned)wid * 1024u;
    const int aoff = lds_byte(wr * 64 + fr, fq * 8), boff = lds_byte(wc * 32 + fr, fq * 8);
#define PG8_SA(b, h) (((b) * 2 + (h)) * HTB)
#define PG8_SB(b, h) ((4 + (b) * 2 + (h)) * HTB)
#define PG8_STAGE(bufoff, gbase, voff) do { _Pragma("unroll") for (int _i = 0; _i < 2; ++_i) \
        __builtin_amdgcn_global_load_lds((const unsigned*)((const char*)(gbase) + (voff)[_i]), (PG8_LAS unsigned*)(lds + (bufoff) + ldsw + _i * 8192), 16, 0, 0); } while (0)
#define PG8_LDA(dst, b, h) do { _Pragma("unroll") for (int m = 0; m < 4; ++m) _Pragma("unroll") for (int k = 0; k < 2; ++k) dst[m][k] = *(const PG8_LAS bf16x8*)(lds + PG8_SA(b, h) + aoff + m * 2048 + k * 1024); } while (0)
#define PG8_LDB(dst, b, h) do { _Pragma("unroll") for (int n = 0; n < 2; ++n) _Pragma("unroll") for (int k = 0; k < 2; ++k) dst[n][k] = *(const PG8_LAS bf16x8*)(lds + PG8_SB(b, h) + boff + n * 2048 + k * 1024); } while (0)
#define PG8_MMA(ai, bj, At, Bt) do { __builtin_amdgcn_s_setprio(1); _Pragma("unroll") for (int m = 0; m < 4; ++m) _Pragma("unroll") for (int n = 0; n < 2; ++n) _Pragma("unroll") for (int k = 0; k < 2; ++k) \
        acc[ai][bj][m][n] = __builtin_amdgcn_mfma_f32_16x16x32_bf16(Bt[n][k], At[m][k], acc[ai][bj][m][n], 0, 0, 0); __builtin_amdgcn_s_setprio(0); } while (0)
#define PG8_WAIT_V(n) asm volatile("s_waitcnt vmcnt(" #n ")" ::: "memory")
#define PG8_WAIT_L(n) asm volatile("s_waitcnt lgkmcnt(" #n ")" ::: "memory")
#define PG8_BAR __builtin_amdgcn_s_barrier()
#define PG8_SCHED __builtin_amdgcn_sched_barrier(0)
    Unit cur, nxt; int ui = 0;
    if (!S.next(0, cur)) return;
    f32x4 acc[2][2][4][2];
#pragma unroll
    for (int a = 0; a < 2; ++a)
#pragma unroll
        for (int b = 0; b < 2; ++b)
#pragma unroll
            for (int m = 0; m < 4; ++m)
#pragma unroll
                for (int n = 0; n < 2; ++n) acc[a][b][m][n] = (f32x4){0.f, 0.f, 0.f, 0.f};
    bf16x8 At[4][2], B0[2][2], B1[2][2];
    const char* cA = (const char*)g.A + (size_t)cur.pm * tstep; const char* cB = (const char*)g.Bt + (size_t)cur.pn * tstep;
    S.a_ready(cur);
    if constexpr (SP2) {
        PG8_STAGE(PG8_SB(0, 0), cB, voffB); PG8_STAGE(PG8_SB(0, 1), cB + hstep, voffB); PG8_STAGE(PG8_SA(0, 0), cA, voffA); PG8_STAGE(PG8_SA(0, 1), cA + hstep, voffA);
        if (wr == 1) PG8_BAR;
        PG8_WAIT_V(2); PG8_BAR;
        PG8_STAGE(PG8_SB(1, 0), cB + kstep, voffB); PG8_STAGE(PG8_SA(1, 0), cA + kstep, voffA); PG8_STAGE(PG8_SB(1, 1), cB + hstep + kstep, voffB);
        PG8_WAIT_V(6); PG8_BAR;
    } else {
        PG8_STAGE(PG8_SB(0, 0), cB, voffB); PG8_STAGE(PG8_SA(0, 0), cA, voffA); PG8_STAGE(PG8_SB(0, 1), cB + hstep, voffB); PG8_STAGE(PG8_SA(0, 1), cA + hstep, voffA);
        if (wr == 1) PG8_BAR;
        PG8_WAIT_V(4); PG8_BAR;
        PG8_STAGE(PG8_SB(1, 0), cB + kstep, voffB); PG8_STAGE(PG8_SA(1, 0), cA + kstep, voffA); PG8_STAGE(PG8_SB(1, 1), cB + hstep + kstep, voffB);
        PG8_WAIT_V(6); PG8_BAR;
    }
    for (;;) {
        const bool has_next = S.next(ui + 1, nxt);
        const char* nA = has_next ? (const char*)g.A + (size_t)nxt.pm * tstep : cA; const char* nB = has_next ? (const char*)g.Bt + (size_t)nxt.pn * tstep : cB;
        for (int t = 0; t < nt; t += 2) {
            const bool last = (t == nt - 2);
            const char* a1 = cA + (size_t)(t + 1) * kstep;
            const char* a2 = last ? nA : cA + (size_t)(t + 2) * kstep; const char* b2 = last ? nB : cB + (size_t)(t + 2) * kstep;
            const char* a3 = a2 + kstep; const char* b3 = b2 + kstep;
            if (last && has_next) S.a_ready(nxt);
            if constexpr (SP2) {
            PG8_LDB(B0, 0, 0); PG8_LDB(B1, 0, 1); PG8_SCHED; PG8_LDA(At, 0, 0); PG8_STAGE(PG8_SA(1, 1), a1 + hstep, voffA);
            PG8_WAIT_V(8); PG8_WAIT_L(0); PG8_BAR; PG8_MMA(0, 0, At, B0); PG8_MMA(0, 1, At, B1); PG8_BAR; PG8_SCHED;
            PG8_LDA(At, 0, 1); PG8_STAGE(PG8_SB(0, 0), b2, voffB); PG8_STAGE(PG8_SB(0, 1), b2 + hstep, voffB); PG8_STAGE(PG8_SA(0, 0), a2, voffA);
            PG8_WAIT_V(8); PG8_WAIT_L(0); PG8_BAR; PG8_MMA(1, 0, At, B0); PG8_MMA(1, 1, At, B1); PG8_BAR; PG8_SCHED;
            PG8_LDB(B0, 1, 0); PG8_LDB(B1, 1, 1); PG8_SCHED; PG8_LDA(At, 1, 0); PG8_STAGE(PG8_SA(0, 1), a2 + hstep, voffA);
            PG8_WAIT_V(8); PG8_WAIT_L(0); PG8_BAR; PG8_MMA(0, 0, At, B0); PG8_MMA(0, 1, At, B1); PG8_BAR; PG8_SCHED;
            PG8_LDA(At, 1, 1); PG8_STAGE(PG8_SB(1, 0), b3, voffB); PG8_STAGE(PG8_SB(1, 1), b3 + hstep, voffB); PG8_STAGE(PG8_SA(1, 0), a3, voffA);
            PG8_WAIT_V(8); PG8_WAIT_L(0); PG8_BAR; PG8_MMA(1, 0, At, B0); PG8_MMA(1, 1, At, B1); PG8_BAR; PG8_SCHED;
            } else {
            PG8_LDB(B0, 0, 0); PG8_SCHED; PG8_LDA(At, 0, 0); PG8_STAGE(PG8_SA(1, 1), a1 + hstep, voffA);
            PG8_WAIT_L(8); PG8_BAR; PG8_WAIT_L(0); PG8_MMA(0, 0, At, B0); PG8_BAR; PG8_SCHED;
            PG8_LDB(B1, 0, 1); PG8_STAGE(PG8_SB(0, 0), b2, voffB);
            PG8_BAR; PG8_WAIT_L(0); PG8_MMA(0, 1, At, B1); PG8_BAR;
            PG8_LDA(At, 0, 1); PG8_STAGE(PG8_SA(0, 0), a2, voffA);
            PG8_BAR; PG8_WAIT_L(0); PG8_MMA(1, 0, At, B0); PG8_BAR; PG8_SCHED;
            PG8_STAGE(PG8_SB(0, 1), b2 + hstep, voffB);
            PG8_WAIT_V(6); PG8_BAR; PG8_MMA(1, 1, At, B1); PG8_BAR;
            PG8_LDB(B0, 1, 0); PG8_SCHED; PG8_LDA(At, 1, 0); PG8_STAGE(PG8_SA(0, 1), a2 + hstep, voffA);
            PG8_WAIT_L(8); PG8_BAR; PG8_WAIT_L(0); PG8_MMA(0, 0, At, B0); PG8_BAR; PG8_SCHED;
            PG8_LDB(B1, 1, 1); PG8_STAGE(PG8_SB(1, 0), b3, voffB);
            PG8_BAR; PG8_WAIT_L(0); PG8_MMA(0, 1, At, B1); PG8_BAR;
            PG8_LDA(At, 1, 1); PG8_STAGE(PG8_SA(1, 0), a3, voffA);
            PG8_BAR; PG8_WAIT_L(0); PG8_MMA(1, 0, At, B0); PG8_BAR; PG8_SCHED;
            PG8_STAGE(PG8_SB(1, 1), b3 + hstep, voffB);
            PG8_WAIT_V(6); PG8_BAR; PG8_MMA(1, 1, At, B1); PG8_BAR;
            }
        }
        if constexpr (ALIGN_EPI) { if (wr == 0) PG8_BAR; }
        if constexpr (!Epi::AFTER_DRAIN) { E(acc, cur, wr, wc, fr, fq); S.done(cur); }
        if (!has_next) break;
#pragma unroll
        for (int a = 0; a < 2; ++a)
#pragma unroll
            for (int b = 0; b < 2; ++b)
#pragma unroll
                for (int m = 0; m < 4; ++m)
#pragma unroll
                    for (int n = 0; n < 2; ++n) acc[a][b][m][n] = (f32x4){0.f, 0.f, 0.f, 0.f};
        cur = nxt; cA = nA; cB = nB; ++ui;
        if constexpr (ALIGN_EPI) { if (wr == 1) PG8_BAR; }
    }
    PG8_WAIT_V(0);
    if constexpr (!ALIGN_EPI) { if (wr == 0) PG8_BAR; }
    PG8_BAR;
    if constexpr (Epi::AFTER_DRAIN) { E.fused(acc, cur, wr, wc, fr, fq, lds, wid, lane); S.done(cur); }
#undef PG8_SA
#undef PG8_SB
#undef PG8_STAGE
#undef PG8_LDA
#undef PG8_LDB
#undef PG8_MMA
#undef PG8_WAIT_V
#undef PG8_WAIT_L
#undef PG8_BAR
#undef PG8_SCHED
}
}

#ifndef PG8_SP2
#define PG8_SP2 true
#endif
#ifndef PG8_ALIGN
#define PG8_ALIGN true
#endif

#define LAS __attribute__((address_space(3)))
typedef unsigned short bf16_t;
typedef short bf16x8 __attribute__((ext_vector_type(8)));
typedef short s16x4 __attribute__((ext_vector_type(4)));
typedef float f32x4 __attribute__((ext_vector_type(4)));
typedef float f32x2 __attribute__((ext_vector_type(2)));
typedef float f32x16 __attribute__((ext_vector_type(16)));
typedef unsigned u32x4 __attribute__((ext_vector_type(4)));
typedef unsigned u32x2 __attribute__((ext_vector_type(2)));
typedef __bf16 bf16x2_t __attribute__((ext_vector_type(2)));
typedef LAS unsigned char* ldsp;

constexpr int T = 16384, SEQ = 4096, NB = 4, D = 1024, DFF = 2816, NUP = 5632, MEMT = 1024;
constexpr float EPS = 1e-6f, LOG2E = 1.4426950408889634f;
constexpr size_t MiB = 1u << 20;
constexpr size_t WS_CTL = 0, WS_MISC = 65536;
constexpr size_t WS_WIN0 = 1 * MiB, WS_WOUT0 = 7 * MiB, WS_WQ = 9 * MiB, WS_WKV = 13 * MiB, WS_WO = 21 * MiB, WS_WUP = 25 * MiB, WS_WDN = 47 * MiB, WS_WIN1 = 58 * MiB, WS_WOUT1 = 64 * MiB;
constexpr size_t WS_SSQ = 66 * MiB, WS_SSQM = 67 * MiB, WS_GATE = 68 * MiB, WS_MEMB = 69 * MiB, WS_KV = 71 * MiB, WS_CH = 79 * MiB, WS_NST = 79 * MiB + 512 * 1024;
constexpr size_t WS_XB = 80 * MiB, WS_R2 = 112 * MiB, WS_R1 = 144 * MiB, WS_END = 240 * MiB;
constexpr size_t WS_CWP = 79 * MiB + 64 * 1024;
constexpr int LDS_BYTES = 159744, LDS_X = 131072, LDS_RSTAB = LDS_X + 12544, LDS_CWPS = LDS_X + 18688;

__device__ __forceinline__ unsigned cvtpk(float lo, float hi) { f32x2 v = {lo, hi}; bf16x2_t b = __builtin_convertvector(v, bf16x2_t); return __builtin_bit_cast(unsigned, b); }
__device__ __forceinline__ float bflo(unsigned u) { return __uint_as_float(u << 16); }
__device__ __forceinline__ float bfhi(unsigned u) { return __uint_as_float(u & 0xffff0000u); }
__device__ __forceinline__ float bf2f(bf16_t v) { return __uint_as_float(((unsigned)v) << 16); }
__device__ __forceinline__ bf16_t f2bf(float f) { return (bf16_t)(cvtpk(f, 0.f) & 0xffffu); }
__device__ __forceinline__ float wave_sum(float v) {
#pragma unroll
    for (int o = 1; o < 64; o <<= 1) v += __shfl_xor(v, o);
    return v;
}
__device__ __forceinline__ float ex2(float x) { return __builtin_amdgcn_exp2f(x); }
__device__ __forceinline__ float log_sigmoid(float z) { return fminf(z, 0.f) - __logf(1.f + __expf(-fabsf(z))); }
__device__ __forceinline__ float ror1(float v) { return __builtin_bit_cast(float, __builtin_amdgcn_update_dpp(0, __builtin_bit_cast(int, v), 0x121, 0xf, 0xf, false)); }
__device__ __forceinline__ float ror2(float v) { return __builtin_bit_cast(float, __builtin_amdgcn_update_dpp(0, __builtin_bit_cast(int, v), 0x122, 0xf, 0xf, false)); }
__device__ __forceinline__ float gelu_tanh(float x) { return x * __builtin_amdgcn_rcpf(1.f + ex2(-2.302208198f * (x + 0.044715f * x * x * x))); }
__device__ __forceinline__ int crow(int r, int h) { return (r & 3) + 8 * (r >> 2) + 4 * h; }
typedef short v4i16_t __attribute__((ext_vector_type(4)));
__device__ __forceinline__ bf16x8 tr8(ldsp p, int hi_off) {
    s16x4 lo = __builtin_bit_cast(s16x4, __builtin_amdgcn_ds_read_tr16_b64_v4i16((LAS v4i16_t*)p));
    s16x4 hi = __builtin_bit_cast(s16x4, __builtin_amdgcn_ds_read_tr16_b64_v4i16((LAS v4i16_t*)(p + hi_off)));
    return __builtin_shufflevector(lo, hi, 0, 1, 2, 3, 4, 5, 6, 7);
}
__device__ __forceinline__ bf16x8 pack8(const f32x16& x, int s) {
    u32x4 p; p.x = cvtpk(x[8 * s], x[8 * s + 1]); p.y = cvtpk(x[8 * s + 2], x[8 * s + 3]); p.z = cvtpk(x[8 * s + 4], x[8 * s + 5]); p.w = cvtpk(x[8 * s + 6], x[8 * s + 7]);
    return __builtin_bit_cast(bf16x8, p);
}
__device__ __forceinline__ int otid() { int t = threadIdx.x; asm volatile("" : "+v"(t)); return t; }
#define MFMA32(a, b, c) __builtin_amdgcn_mfma_f32_32x32x16_bf16((a), (b), (c), 0, 0, 0)

__device__ __forceinline__ float rstd_from_ssq(const float* ssq, int row) {
    const f32x4* p = (const f32x4*)(ssq + (size_t)row * 16);
    f32x4 a = p[0], b = p[1], c = p[2], d = p[3];
    float s = ((a.x + a.y) + (a.z + a.w)) + ((b.x + b.y) + (b.z + b.w)) + ((c.x + c.y) + (c.z + c.w)) + ((d.x + d.y) + (d.z + d.w));
    return rsqrtf(s * (1.0f / 1024.0f) + EPS);
}
struct EpiScaled {
    static constexpr bool PERM = true, AFTER_DRAIN = false;
    bf16_t* O; int plane_cols; size_t plane_stride; int ldc; const float* ssq; float qscale; unsigned qmask;
    __device__ __forceinline__ void operator()(const f32x4 (&acc)[2][2][4][2], const pg8::Unit& u, int wr, int wc, int fr, int fq) const {
        const int row0 = u.pm * 256 + wr * 64 + fr;
#pragma unroll
        for (int ai = 0; ai < 2; ++ai)
#pragma unroll
            for (int m = 0; m < 4; ++m) {
                const int row = row0 + ai * 128 + m * 16;
                const float rs = rstd_from_ssq(ssq, row);
#pragma unroll
                for (int bj = 0; bj < 2; ++bj) {
                    const int c = u.pn * 256 + 128 * bj + 32 * wc + 8 * fq;
                    const int pl = c / plane_cols, cc = c - pl * plane_cols;
                    const float sc = ((qmask >> pl) & 1u) ? rs * qscale : rs;
                    const f32x4 v0 = acc[ai][bj][m][0] * sc, v1 = acc[ai][bj][m][1] * sc;
                    u32x4 w; w.x = cvtpk(v0[0], v0[1]); w.y = cvtpk(v0[2], v0[3]); w.z = cvtpk(v1[0], v1[1]); w.w = cvtpk(v1[2], v1[3]);
                    *(u32x4*)(O + (size_t)pl * plane_stride + (size_t)row * ldc + cc) = w;
                }
            }
    }
};
struct EpiScaledT {
    static constexpr bool PERM = true, AFTER_DRAIN = false;
    bf16_t* O; int plane_cols; size_t plane_stride; int ldc; const LAS float* rstab; float qscale; unsigned qmask; mutable int ord = 0;
    __device__ __forceinline__ void operator()(const f32x4 (&acc)[2][2][4][2], const pg8::Unit& u, int wr, int wc, int fr, int fq) const {
        const int row0 = u.pm * 256 + wr * 64 + fr;
        const int o = ord++;
#pragma unroll
        for (int ai = 0; ai < 2; ++ai)
#pragma unroll
            for (int m = 0; m < 4; ++m) {
                const int row = row0 + ai * 128 + m * 16;
                const float rs = rstab[o * 256 + (row & 255)];
#pragma unroll
                for (int bj = 0; bj < 2; ++bj) {
                    const int c = u.pn * 256 + 128 * bj + 32 * wc + 8 * fq;
                    const int pl = c / plane_cols, cc = c - pl * plane_cols;
                    const float sc = ((qmask >> pl) & 1u) ? rs * qscale : rs;
                    const f32x4 v0 = acc[ai][bj][m][0] * sc, v1 = acc[ai][bj][m][1] * sc;
                    u32x4 w; w.x = cvtpk(v0[0], v0[1]); w.y = cvtpk(v0[2], v0[3]); w.z = cvtpk(v1[0], v1[1]); w.w = cvtpk(v1[2], v1[3]);
                    *(u32x4*)(O + (size_t)pl * plane_stride + (size_t)row * ldc + cc) = w;
                }
            }
    }
};
struct EpiRes {
    static constexpr bool PERM = true, AFTER_DRAIN = false;
    const float* basef; bf16_t* xb; float* ssq;
    __device__ __forceinline__ void operator()(const f32x4 (&acc)[2][2][4][2], const pg8::Unit& u, int wr, int wc, int fr, int fq) const {
        const int row0 = u.pm * 256 + wr * 64 + fr;
#pragma unroll
        for (int ai = 0; ai < 2; ++ai)
#pragma unroll
            for (int m = 0; m < 4; ++m) {
                const int row = row0 + ai * 128 + m * 16;
                float ss = 0.f;
#pragma unroll
                for (int bj = 0; bj < 2; ++bj) {
                    const int c = u.pn * 256 + 128 * bj + 32 * wc + 8 * fq;
                    const size_t off = (size_t)row * D + c;
                    f32x4 b0, b1;
                    if (basef) { b0 = *(const f32x4*)(basef + off); b1 = *(const f32x4*)(basef + off + 4); }
                    else { const u32x4 r = *(const u32x4*)(xb + off); b0 = (f32x4){bflo(r.x), bfhi(r.x), bflo(r.y), bfhi(r.y)}; b1 = (f32x4){bflo(r.z), bfhi(r.z), bflo(r.w), bfhi(r.w)}; }
                    const f32x4 v0 = b0 + acc[ai][bj][m][0], v1 = b1 + acc[ai][bj][m][1];
                    u32x4 w; w.x = cvtpk(v0[0], v0[1]); w.y = cvtpk(v0[2], v0[3]); w.z = cvtpk(v1[0], v1[1]); w.w = cvtpk(v1[2], v1[3]);
                    *(u32x4*)(xb + off) = w;
                    const float q0 = bflo(w.x), q1 = bfhi(w.x), q2 = bflo(w.y), q3 = bfhi(w.y), q4 = bflo(w.z), q5 = bfhi(w.z), q6 = bflo(w.w), q7 = bfhi(w.w);
                    ss += (q0 * q0 + q1 * q1) + (q2 * q2 + q3 * q3) + (q4 * q4 + q5 * q5) + (q6 * q6 + q7 * q7);
                }
                ss += __shfl_xor(ss, 16); ss += __shfl_xor(ss, 32);
                if (fq == 0) ssq[(size_t)row * 16 + u.pn * 4 + wc] = ss;
            }
    }
};

__device__ __forceinline__ float shr1(float v) { return __builtin_bit_cast(float, __builtin_amdgcn_update_dpp(0, __builtin_bit_cast(int, v), 0x111, 0xf, 0xf, true)); }
struct EpiUp {
    static constexpr bool PERM = true, AFTER_DRAIN = false, APERM = true;
    bf16_t* act; float* head; float* tail; const float* ssq; const float* cwp; const LAS float* rstab; LAS float* cwps; mutable int ord = 0;
    __device__ __forceinline__ void operator()(const f32x4 (&acc)[2][2][4][2], const pg8::Unit& u, int wr, int wc, int fr, int fq) const {
        const int j0 = u.pn * 128 + 32 * wc + 8 * fq;
        const int o = ord++;
        LAS float* cs = cwps + (wr * 4 + wc) * 256;
        *(LAS f32x4*)(cs + (fq * 16 + fr) * 4) = *(const f32x4*)(cwp + (size_t)(u.pn * 128 + 32 * wc) * 8 + (fq * 16 + fr) * 4);
#pragma unroll
        for (int ai = 0; ai < 2; ++ai) {
            const int grp = u.pm * 4 + ai * 2 + wr;
            float rs[4];
#pragma unroll
            for (int m = 0; m < 4; ++m) rs[m] = rstab[o * 256 + ((grp & 3) * 64 + 4 * fr + m)];
#pragma unroll
            for (int n = 0; n < 2; ++n) {
                unsigned res[4][2];
#pragma unroll
                for (int ep = 0; ep < 2; ++ep) {
                    const LAS f32x4* cq = (const LAS f32x4*)(cs + (4 * fq + 2 * n + ep) * 16);
                    const f32x4 A0 = cq[0], A1 = cq[1], A2 = cq[2], A3 = cq[3];
                    const f32x2 W0g = {A0[0], A0[1]}, W1g = {A0[2], A0[3]}, W2g = {A1[0], A1[1]}, Bg = {A1[2], A1[3]};
                    const f32x2 W0u = {A2[0], A2[1]}, W1u = {A2[2], A2[3]}, W2u = {A3[0], A3[1]}, Bu = {A3[2], A3[3]};
                    f32x2 Gv[4], Uv[4];
#pragma unroll
                    for (int m = 0; m < 4; ++m) { Gv[m] = (f32x2){acc[ai][0][m][n][2 * ep], acc[ai][0][m][n][2 * ep + 1]} * rs[m]; Uv[m] = (f32x2){acc[ai][1][m][n][2 * ep], acc[ai][1][m][n][2 * ep + 1]} * rs[m]; }
                    const f32x2 g3s = {shr1(Gv[3].x), shr1(Gv[3].y)}, g2s = {shr1(Gv[2].x), shr1(Gv[2].y)}, u3s = {shr1(Uv[3].x), shr1(Uv[3].y)}, u2s = {shr1(Uv[2].x), shr1(Uv[2].y)};
                    f32x2 hg[4], hu[4];
                    hg[0] = W0g * g2s + W1g * g3s + W2g * Gv[0] + Bg;     hu[0] = W0u * u2s + W1u * u3s + W2u * Uv[0] + Bu;
                    hg[1] = W0g * g3s + W1g * Gv[0] + W2g * Gv[1] + Bg;   hu[1] = W0u * u3s + W1u * Uv[0] + W2u * Uv[1] + Bu;
                    hg[2] = W0g * Gv[0] + W1g * Gv[1] + W2g * Gv[2] + Bg; hu[2] = W0u * Uv[0] + W1u * Uv[1] + W2u * Uv[2] + Bu;
                    hg[3] = W0g * Gv[1] + W1g * Gv[2] + W2g * Gv[3] + Bg; hu[3] = W0u * Uv[1] + W1u * Uv[2] + W2u * Uv[3] + Bu;
                    const int j = j0 + 4 * n + 2 * ep;
                    if (fr == 0) { float* hp = head + (size_t)(grp * 2) * NUP + j; *(f32x2*)hp = Gv[0]; *(f32x2*)(hp + DFF) = Uv[0]; *(f32x2*)(hp + NUP) = Gv[1]; *(f32x2*)(hp + NUP + DFF) = Uv[1]; }
                    if (fr == 15) { float* tp = tail + (size_t)(grp * 2) * NUP + j; *(f32x2*)tp = Gv[2]; *(f32x2*)(tp + DFF) = Uv[2]; *(f32x2*)(tp + NUP) = Gv[3]; *(f32x2*)(tp + NUP + DFF) = Uv[3]; }
#pragma unroll
                    for (int m = 0; m < 4; ++m) {
                        const f32x2 x = hg[m], t = x * (x * x * 0.044715f + 1.0f) * (-2.302208198f);
                        const f32x2 den = (f32x2){ex2(t.x), ex2(t.y)} + 1.0f;
                        const f32x2 val = x * hu[m] * (f32x2){__builtin_amdgcn_rcpf(den.x), __builtin_amdgcn_rcpf(den.y)};
                        res[m][ep] = cvtpk(val.x, val.y);
                    }
                }
#pragma unroll
                for (int m = 0; m < 4; ++m) {
                    if (m >= 2 || fr > 0) { u32x2 w; w.x = res[m][0]; w.y = res[m][1];
                        *(u32x2*)(act + (size_t)(grp * 64 + 4 * fr + m) * DFF + j0 + 4 * n) = w; }
                }
                asm volatile("" ::: "memory");
            }
        }
    }
};

template <class Sched>
__device__ __forceinline__ void rstab_fill(ldsp lds, const Sched S, const float* ssq) {
    LAS float* tab = (LAS float*)(lds + LDS_RSTAB);
    const int t = otid();
#pragma unroll
    for (int i = 0; i < 6; ++i) { pg8::Unit fu; if (S.next(i, fu) && t < 256) tab[i * 256 + t] = rstd_from_ssq(ssq, fu.pm * 256 + t); }
    __syncthreads();
}
#define XB_TMO      128
#define XB_XCNT(j)  (256  + 64 * (j))
#define XB_XSUB(j)  (1280 + 64 * (j))
#define XB_XGEN(j)  (2304 + 64 * (j))
#define XB_TOP      3328
#define XB_TOPGEN   3392
#define XCD_BAR_WORDS 3456
#define XB_SPIN_CAP (1u << 18)
__device__ __forceinline__ unsigned xb_ld(unsigned* p)              { return __hip_atomic_load(p, __ATOMIC_RELAXED, __HIP_MEMORY_SCOPE_AGENT); }
__device__ __forceinline__ unsigned xb_add(unsigned* p, unsigned v) { return __hip_atomic_fetch_add(p, v, __ATOMIC_RELAXED, __HIP_MEMORY_SCOPE_AGENT); }
__device__ __forceinline__ unsigned xb_xcc_id() { return (unsigned)__builtin_amdgcn_s_getreg((3 << 11) | 20) & 0xFu; }
#define XB_SPIN(cond, bar) do { unsigned _sp = 0; while (cond) { __builtin_amdgcn_s_sleep(1); \
    if ((++_sp & 255u) == 0u) { if (xb_ld(&(bar)[XB_TMO])) break; if (_sp > XB_SPIN_CAP) { atomicAdd(&(bar)[XB_TMO], 1u); break; } } } } while (0)

struct XcdBarrier {
    unsigned* bar; unsigned x;
    volatile LAS unsigned* st;
};

__device__ __forceinline__ XcdBarrier xcd_barrier_post(unsigned* bar, volatile LAS unsigned* st) {
    XcdBarrier b; b.bar = bar; b.x = xb_xcc_id(); b.st = st;
    if (threadIdx.x == 0) (void)xb_add(&bar[XB_XCNT(b.x)], 1u);
    return b;
}
__device__ __forceinline__ void xcd_barrier_complete(unsigned* bar, unsigned x, unsigned& nloc, unsigned& nx) {
    const unsigned G = gridDim.x * gridDim.y * gridDim.z;
    unsigned sum, cnt, mine, sp = 0u;
    for (;;) {
        sum = 0u; cnt = 0u; mine = 0u;
#pragma unroll
        for (unsigned j = 0; j < 16; ++j) { const unsigned c = xb_ld(&bar[XB_XCNT(j)]); sum += c; cnt += (c > 0u) ? 1u : 0u; mine = (j == x) ? c : mine; }
        if (sum == G) break;
        __builtin_amdgcn_s_sleep(1);
        if ((++sp & 255u) == 0u) { if (xb_ld(&bar[XB_TMO])) break; if (sp > XB_SPIN_CAP) { atomicAdd(&bar[XB_TMO], 1u); break; } }
    }
    nloc = mine > 0u ? mine : 1u; nx = cnt > 0u ? cnt : 1u;
}

__device__ __forceinline__ void xcd_barrier(const XcdBarrier& b) {
    asm volatile("s_waitcnt vmcnt(0)" ::: "memory");
    __syncthreads();
    if (threadIdx.x == 0) {
        unsigned* bar = b.bar;
        __builtin_amdgcn_s_waitcnt(0);
        unsigned nloc = b.st[0], nx = b.st[1];
        if (nloc == 0u) { xcd_barrier_complete(bar, b.x, nloc, nx); b.st[0] = nloc; b.st[1] = nx; }
        const unsigned old = xb_add(&bar[XB_XSUB(b.x)], 1u);
        const unsigned gen = old / nloc;
        if (old + 1u == (gen + 1u) * nloc) {
            __builtin_amdgcn_fence(__ATOMIC_RELEASE, "agent");
            asm volatile("s_waitcnt vmcnt(0)" ::: "memory");
            const unsigned og = xb_add(&bar[XB_TOP], 1u);
            const unsigned tg = og / nx;
            if (og + 1u == (tg + 1u) * nx) xb_add(&bar[XB_TOPGEN], 1u);
            else XB_SPIN(xb_ld(&bar[XB_TOPGEN]) == tg, bar);
            __builtin_amdgcn_fence(__ATOMIC_ACQUIRE, "agent");
            xb_add(&bar[XB_XGEN(b.x)], 1u);
            asm volatile("s_waitcnt vmcnt(0)" ::: "memory");
        } else {
            XB_SPIN(xb_ld(&bar[XB_XGEN(b.x)]) == gen, bar);
            __builtin_amdgcn_fence(__ATOMIC_ACQUIRE, "agent");
            asm volatile("s_waitcnt vmcnt(0)" ::: "memory");
        }
    }
    __syncthreads();
}


struct Args { const float* in[28]; float* out; unsigned char* ws; };

__device__ __forceinline__ void wt_item(const float* W, int K, int Nsrc, int srccol0, bf16_t* WT, int dstrow0, const float* gain, int k0, ldsp scr, int lane) {
    const int c4 = lane & 15, rr = lane >> 4;
    f32x4 w[16];
#pragma unroll
    for (int i = 0; i < 16; ++i) w[i] = *(const f32x4*)(W + (size_t)(k0 + 4 * i + rr) * Nsrc + srccol0 + 4 * c4);
#pragma unroll
    for (int i = 0; i < 16; ++i) { const float g = gain ? gain[k0 + 4 * i + rr] : 1.f; const unsigned a = cvtpk(w[i].x * g, w[i].y * g), b = cvtpk(w[i].z * g, w[i].w * g);
        ldsp p = scr + (4 * c4) * 132 + (4 * i + rr) * 2;
        *(LAS bf16_t*)(p) = (bf16_t)(a & 0xffffu); *(LAS bf16_t*)(p + 132) = (bf16_t)(a >> 16); *(LAS bf16_t*)(p + 264) = (bf16_t)(b & 0xffffu); *(LAS bf16_t*)(p + 396) = (bf16_t)(b >> 16); }
    asm volatile("s_waitcnt lgkmcnt(0)" ::: "memory");
    const int c = lane & 7;
#pragma unroll
    for (int j = 0; j < 8; ++j) { const int n = 8 * j + (lane >> 3); const LAS unsigned* s = (const LAS unsigned*)(scr + n * 132 + c * 16);
        u32x4 o; o.x = s[0]; o.y = s[1]; o.z = s[2]; o.w = s[3];
        *(u32x4*)(WT + (size_t)(dstrow0 + n) * K + k0 + 8 * c) = o; }
    asm volatile("s_waitcnt lgkmcnt(0)" ::: "memory");
}
__device__ __forceinline__ void wt_dispatch(const Args& A, int it, ldsp scr, int lane) {
    const float* W; bf16_t* WT; const float* gain = nullptr; int K = 1024, Nsrc, Ndst, mode = 0, r = it;
    unsigned char* ws = A.ws;
    if (r < 768) { W = A.in[6]; WT = (bf16_t*)(ws + WS_WIN0); gain = A.in[2]; Nsrc = 3080; Ndst = 3072; mode = 1; }
    else if ((r -= 768) < 256) { W = A.in[13]; WT = (bf16_t*)(ws + WS_WOUT0); Nsrc = 1024; Ndst = 1024; }
    else if ((r -= 256) < 512) { const int l = r / 256; r -= l * 256; W = A.in[20] + (size_t)l * 1024 * 1024; WT = (bf16_t*)(ws + WS_WQ) + (size_t)l * 1024 * 1024; gain = A.in[3] + l * 1024; Nsrc = 1024; Ndst = 1024; }
    else if ((r -= 512) < 1024) { const int l = r / 512; r -= l * 512; W = A.in[21] + (size_t)l * 1024 * 2048; WT = (bf16_t*)(ws + WS_WKV) + (size_t)l * 2048 * 1024; gain = A.in[4] + l * 1024; Nsrc = 2048; Ndst = 2048; }
    else if ((r -= 1024) < 512) { const int l = r / 256; r -= l * 256; W = A.in[22] + (size_t)l * 1024 * 1024; WT = (bf16_t*)(ws + WS_WO) + (size_t)l * 1024 * 1024; Nsrc = 1024; Ndst = 1024; }
    else if ((r -= 512) < 2816) { const int l = r / 1408; r -= l * 1408; W = A.in[23] + (size_t)l * 1024 * NUP; WT = (bf16_t*)(ws + WS_WUP) + (size_t)l * NUP * 1024; gain = A.in[5] + l * 1024; Nsrc = NUP; Ndst = NUP; mode = 3; }
    else if ((r -= 2816) < 1408) { const int l = r / 704; r -= l * 704; W = A.in[26] + (size_t)l * DFF * 1024; WT = (bf16_t*)(ws + WS_WDN) + (size_t)l * 1024 * DFF; K = DFF; Nsrc = 1024; Ndst = 1024; }
    else if ((r -= 1408) < 768) { W = A.in[14]; WT = (bf16_t*)(ws + WS_WIN1); gain = A.in[2] + 1024; Nsrc = 3080; Ndst = 3072; mode = 2; }
    else { r -= 768; W = A.in[19]; WT = (bf16_t*)(ws + WS_WOUT1); Nsrc = 1024; Ndst = 1024; }
    const int nblk = Ndst / 64, kb = r / nblk, nb = r % nblk, n0 = nb * 64;
    int sc = n0;
    if (mode == 1) sc = n0 < 1536 ? n0 : n0 + 8;
    else if (mode == 2) sc = n0 < 2048 ? n0 : n0 + 8;
    else if (mode == 3) { const int p = n0 >> 8, i = n0 & 255; sc = i < 128 ? 128 * p + i : DFF + 128 * p + (i - 128); }
    wt_item(W, K, Nsrc, sc, WT, n0, gain, kb * 64, scr, lane);
}
constexpr int WT_ITEMS = 8320;

template <int MODE>
__device__ __forceinline__ void row_pass(const Args& A, ldsp lds, const float* X, const float* Wg, int col0, const float* gain, int gw, int ngw, int tid, int lane) {
    LAS float* gwl = (LAS float*)lds;
    for (int i = tid; i < 1024 * 2; i += 512) { const int k = i >> 1, hf = i & 1; const f32x4 w = *(const f32x4*)(Wg + (size_t)k * 3080 + col0 + 4 * hf); const float g = gain[k];
        gwl[(4 * hf + 0) * 1024 + k] = w.x * g; gwl[(4 * hf + 1) * 1024 + k] = w.y * g; gwl[(4 * hf + 2) * 1024 + k] = w.z * g; gwl[(4 * hf + 3) * 1024 + k] = w.w * g; }
    __syncthreads();
    unsigned char* ws = A.ws;
    bf16_t* xb = (bf16_t*)(ws + WS_XB); float* ssq = (float*)(ws + WS_SSQ); float* gate = (float*)(ws + WS_GATE);
    f32x4 nx[4];
    if (gw < T) {
#pragma unroll
        for (int j = 0; j < 4; ++j) nx[j] = ((const f32x4*)(X + (size_t)gw * D) + lane)[64 * j];
    }
    for (int m = gw; m < T; m += ngw) {
        f32x4 v[4]; float s = 0.f;
#pragma unroll
        for (int j = 0; j < 4; ++j) { v[j] = nx[j]; s += (v[j].x * v[j].x + v[j].y * v[j].y) + (v[j].z * v[j].z + v[j].w * v[j].w); }
        if (m + ngw < T) {
#pragma unroll
            for (int j = 0; j < 4; ++j) nx[j] = ((const f32x4*)(X + (size_t)(m + ngw) * D) + lane)[64 * j];
        }
        s = wave_sum(s);
        const float rstd = rsqrtf(s * (1.0f / 1024.0f) + EPS);
        if (MODE == 0) {
            u32x2* o8 = (u32x2*)(xb + (size_t)m * D) + lane;
#pragma unroll
            for (int j = 0; j < 4; ++j) { u32x2 w; w.x = cvtpk(v[j].x, v[j].y); w.y = cvtpk(v[j].z, v[j].w); o8[64 * j] = w; }
            if (lane < 16) ssq[(size_t)m * 16 + lane] = lane == 0 ? s : 0.f;
        }
        float z[8];
#pragma unroll
        for (int c = 0; c < 8; ++c) { float d = 0.f;
#pragma unroll
            for (int j = 0; j < 4; ++j) { const f32x4 w = *(const LAS f32x4*)(gwl + c * 1024 + 256 * j + 4 * lane); d += (v[j].x * w.x + v[j].y * w.y) + (v[j].z * w.z + v[j].w * w.w); }
            z[c] = wave_sum(d) * rstd; }
        float zc = z[0];
#pragma unroll
        for (int c = 1; c < 8; ++c) zc = lane == c ? z[c] : zc;
        const int b = m >> 12, t = m & 4095;
        if (MODE == 0) { if (lane < 8) gate[(size_t)(b * 8 + lane) * SEQ + t] = log_sigmoid(zc + A.in[7][lane]); }
        else { if (lane < 4) gate[(size_t)(b * 4 + lane) * SEQ + t] = zc + A.in[16][lane];
               else if (lane < 8) gate[(size_t)(16 + b * 4 + lane - 4) * SEQ + t] = log_sigmoid(zc + A.in[17][lane - 4]); }
    }
    __syncthreads();
}

__device__ __forceinline__ void seq_cumsum(float* p, float scale, LAS float* scr, int tid, int lane, int wid) {
    f32x4 a = ((const f32x4*)p)[2 * tid], b = ((const f32x4*)p)[2 * tid + 1];
    a.y += a.x; a.z += a.y; a.w += a.z; b.x += a.w; b.y += b.x; b.z += b.y; b.w += b.z;
    float tot = b.w, inc = tot;
#pragma unroll
    for (int o = 1; o < 64; o <<= 1) { const float n = __shfl_up(inc, o); if (lane >= o) inc += n; }
    if (lane == 63) scr[wid] = inc;
    __syncthreads();
    float pre = inc - tot;
    for (int w = 0; w < wid; ++w) pre += scr[w];
    a = (a + pre) * scale; b = (b + pre) * scale;
    ((f32x4*)p)[2 * tid] = a; ((f32x4*)p)[2 * tid + 1] = b;
    __syncthreads();
}

__device__ __forceinline__ float max3f(float a, float b, float c) { float r; asm("v_max3_f32 %0, %1, %2, %3" : "=v"(r) : "v"(a), "v"(b), "v"(c)); return r; }
template <int DQK, int DV, int MODE> struct FC {
    static constexpr int KT = (MODE == 1) ? 128 : 64;
    static constexpr int PK = DQK * 2 + 16, PV = DV * 2 + 64, KB = KT * PK, VB = KT * PV, STAGE = KB + VB + KT * 4;
    static constexpr int NCK = KT * DQK / 8 / 512, NCV = KT * DV / 8 / 512;
};
template <int DQK, int DV, int MODE, int NCK, int NCV>
__device__ __forceinline__ void fl_gload(u32x4 (&kr)[NCK], u32x4 (&vr)[NCV], float& fr_, const bf16_t* K, int kp, const bf16_t* V, int vp, const float* Fl, int kv0, int tid, int part = 3) {
    if (part & 1)
#pragma unroll
    for (int i = 0; i < NCK; ++i) { const int cid = tid + 512 * i, row = cid / (DQK / 8), cc = cid % (DQK / 8); kr[i] = *(const u32x4*)(K + (size_t)(kv0 + row) * kp + cc * 8); }
    if (part & 2)
#pragma unroll
    for (int i = 0; i < NCV; ++i) { const int cid = tid + 512 * i, row = cid / (DV / 8), cc = cid % (DV / 8); vr[i] = *(const u32x4*)(V + (size_t)(kv0 + row) * vp + cc * 8); }
    if (MODE == 1 && (part & 1)) { if (tid < FC<DQK, DV, MODE>::KT) fr_ = Fl[kv0 + tid]; }
}
template <int DQK, int DV, int MODE, int NCK, int NCV>
__device__ __forceinline__ void fl_sstore(ldsp st, const u32x4 (&kr)[NCK], const u32x4 (&vr)[NCV], float fr_, int tid) {
    typedef FC<DQK, DV, MODE> C;
#pragma unroll
    for (int i = 0; i < C::NCK; ++i) { const int cid = tid + 512 * i, row = cid / (DQK / 8), cc = cid % (DQK / 8); *(LAS u32x4*)(st + row * C::PK + cc * 16) = kr[i]; }
#pragma unroll
    for (int i = 0; i < C::NCV; ++i) { const int cid = tid + 512 * i, row = cid / (DV / 8), cc = cid % (DV / 8); *(LAS u32x4*)(st + C::KB + row * C::PV + cc * 16) = vr[i]; }
    if (MODE == 1) { if (tid < C::KT) *(LAS float*)(st + C::KB + C::VB + tid * 4) = -fr_; }
}
template <int DQK, int DV, int MODE>
__device__ __forceinline__ void flash_unit(ldsp lds, LAS float* wscr, const bf16_t* Q, int qp, const bf16_t* K, int kp, const bf16_t* V, int vp, const float* Fl,
                                           int q0, int ntiles, f32x16 (&o)[DV / 32]) {
    typedef FC<DQK, DV, MODE> C;
    const int tid = otid(), lane = tid & 63, wid = __builtin_amdgcn_readfirstlane(tid >> 6), n = lane & 31, h = lane >> 5;
    const int i16 = lane & 15, q4 = i16 >> 2, p4 = i16 & 3, blk = (lane >> 4) & 1;
    const int qw = q0 + 32 * wid;
    bf16x8 qf[DQK / 16];
#pragma unroll
    for (int st = 0; st < DQK / 16; ++st) qf[st] = *(const bf16x8*)(Q + (size_t)(qw + n) * qp + 16 * st + 8 * h);
#pragma unroll
    for (int db = 0; db < DV / 32; ++db)
#pragma unroll
        for (int r = 0; r < 16; ++r) o[db][r] = 0.f;
    float mrun = -1e30f, lrun = 0.f;
    const int jmax_w = (MODE == 0) ? ntiles - 1 : (qw >> 6);
    u32x4 kr[C::NCK], vr[C::NCV]; float frg = 0.f;
    fl_gload<DQK, DV, MODE, C::NCK, C::NCV>(kr, vr, frg, K, kp, V, vp, Fl, 0, tid);
    fl_sstore<DQK, DV, MODE, C::NCK, C::NCV>(lds, kr, vr, frg, tid);
    __syncthreads();
    constexpr int SUBS = C::KT / 64;
    if (wid >= 4) __builtin_amdgcn_s_setprio(1);
    for (int j0 = 0; j0 < ntiles; j0 += SUBS) {
        ldsp st = lds + ((j0 / SUBS) & 1) * C::STAGE;
        if (j0 + SUBS < ntiles) fl_gload<DQK, DV, MODE, C::NCK, C::NCV>(kr, vr, frg, K, kp, V, vp, Fl, 64 * (j0 + SUBS), tid, 3);
#pragma unroll
        for (int sub = 0; sub < SUBS; ++sub) {
        const int j = j0 + sub;
        if (j <= jmax_w) {
            f32x16 p0, p1;
            if (MODE == 1) {
                const LAS float* fb = (const LAS float*)(st + C::KB + C::VB) + 64 * sub;
#pragma unroll
                for (int g = 0; g < 4; ++g) { const f32x4 f0 = *(const LAS f32x4*)(fb + 8 * g + 4 * h), f1 = *(const LAS f32x4*)(fb + 32 + 8 * g + 4 * h);
#pragma unroll
                    for (int e = 0; e < 4; ++e) { p0[4 * g + e] = f0[e]; p1[4 * g + e] = f1[e]; } }
            }
            ldsp ka = st + (64 * sub + n) * C::PK + 16 * h;
            const f32x16 zero16 = {0.f, 0.f, 0.f, 0.f, 0.f, 0.f, 0.f, 0.f, 0.f, 0.f, 0.f, 0.f, 0.f, 0.f, 0.f, 0.f};
#pragma unroll
            for (int s = 0; s < DQK / 16; ++s) {
                const bf16x8 a0 = *(const LAS bf16x8*)(ka + 32 * s), a1 = *(const LAS bf16x8*)(ka + 32 * C::PK + 32 * s);
                if (MODE != 1 && s == 0) { p0 = MFMA32(a0, qf[s], zero16); p1 = MFMA32(a1, qf[s], zero16); }
                else { p0 = MFMA32(a0, qf[s], p0); p1 = MFMA32(a1, qf[s], p1); }
            }
            if (MODE == 1) {
                if (j == jmax_w) { const int ql = qw - 64 * j + n;
#pragma unroll
                    for (int r = 0; r < 16; ++r) { const int kvl = crow(r, h); if (kvl > ql) p0[r] = -INFINITY; if (kvl + 32 > ql) p1[r] = -INFINITY; } }
            }
            float mx = fmaxf(p0[0], p1[0]);
#pragma unroll
            for (int r = 1; r < 16; ++r) mx = max3f(mx, p0[r], p1[r]);
            mx = fmaxf(mx, __shfl_xor(mx, 32));
            float alpha = 1.0f;
            if (__any(mx - mrun > 8.0f)) {
                const float mnew = fmaxf(mrun, mx); alpha = ex2(mrun - mnew); mrun = mnew;
                wscr[n] = alpha;
                asm volatile("s_waitcnt lgkmcnt(0)" ::: "memory");
#pragma unroll
                for (int g = 0; g < 4; ++g) { const f32x4 a4 = *(const LAS f32x4*)(wscr + 8 * g + 4 * h);
#pragma unroll
                    for (int db = 0; db < DV / 32; ++db)
#pragma unroll
                        for (int e = 0; e < 4; ++e) o[db][4 * g + e] *= a4[e]; }
            }
            f32x2 rs2 = {0.f, 0.f};
#pragma unroll
            for (int r = 0; r < 16; r += 2) {
                const f32x2 a = (f32x2){p0[r], p0[r + 1]} - mrun, b = (f32x2){p1[r], p1[r + 1]} - mrun;
                const f32x2 ea = {ex2(a.x), ex2(a.y)}, eb = {ex2(b.x), ex2(b.y)};
                p0[r] = ea.x; p0[r + 1] = ea.y; p1[r] = eb.x; p1[r + 1] = eb.y;
                rs2 = rs2 + ea + eb;
            }
            lrun = lrun * alpha + (rs2.x + rs2.y);
            ldsp vb = st + C::KB + (64 * sub + 4 * h + q4) * C::PV + blk * 32 + 8 * p4;
#pragma unroll
            for (int ks = 0; ks < 4; ++ks) {
                const bf16x8 pa = (ks & 2) ? pack8(p1, ks & 1) : pack8(p0, ks & 1);
#pragma unroll
                for (int db = 0; db < DV / 32; ++db) {
                    const bf16x8 bv = tr8(vb + (16 * ks) * C::PV + db * 64, 8 * C::PV);
                    o[db] = MFMA32(pa, bv, o[db]);
                }
            }
        }
        }
        if (j0 + SUBS < ntiles) fl_sstore<DQK, DV, MODE, C::NCK, C::NCV>(lds + (((j0 / SUBS) + 1) & 1) * C::STAGE, kr, vr, frg, tid);
        __syncthreads();
    }
    __builtin_amdgcn_s_setprio(0);
    lrun += __shfl_xor(lrun, 32);
    wscr[n] = 1.0f / lrun;
    asm volatile("s_waitcnt lgkmcnt(0)" ::: "memory");
#pragma unroll
    for (int g = 0; g < 4; ++g) { const f32x4 a4 = *(const LAS f32x4*)(wscr + 8 * g + 4 * h);
#pragma unroll
        for (int db = 0; db < DV / 32; ++db)
#pragma unroll
            for (int e = 0; e < 4; ++e) o[db][4 * g + e] *= a4[e]; }
    asm volatile("" ::: "memory");
}

__device__ __forceinline__ void row_gates_b(const Args& A, ldsp lds, const bf16_t* X, const float* Wg, int col0, const float* gain, int gw, int ngw, int tid, int lane) {
    LAS float* gwl = (LAS float*)lds;
    for (int i = tid; i < 1024 * 2; i += 512) { const int k = i >> 1, hf = i & 1; const f32x4 w = *(const f32x4*)(Wg + (size_t)k * 3080 + col0 + 4 * hf); const float g = gain[k];
        gwl[(4 * hf + 0) * 1024 + k] = w.x * g; gwl[(4 * hf + 1) * 1024 + k] = w.y * g; gwl[(4 * hf + 2) * 1024 + k] = w.z * g; gwl[(4 * hf + 3) * 1024 + k] = w.w * g; }
    __syncthreads();
    float* gate = (float*)(A.ws + WS_GATE);
    u32x4 nx[2];
    if (gw < T) { nx[0] = ((const u32x4*)(X + (size_t)gw * D))[lane]; nx[1] = ((const u32x4*)(X + (size_t)gw * D))[64 + lane]; }
    for (int m = gw; m < T; m += ngw) {
        float v[2][8]; float s = 0.f;
#pragma unroll
        for (int j = 0; j < 2; ++j) { const u32x4 r = nx[j];
            v[j][0] = bflo(r.x); v[j][1] = bfhi(r.x); v[j][2] = bflo(r.y); v[j][3] = bfhi(r.y); v[j][4] = bflo(r.z); v[j][5] = bfhi(r.z); v[j][6] = bflo(r.w); v[j][7] = bfhi(r.w);
#pragma unroll
            for (int e = 0; e < 8; ++e) s += v[j][e] * v[j][e]; }
        if (m + ngw < T) { nx[0] = ((const u32x4*)(X + (size_t)(m + ngw) * D))[lane]; nx[1] = ((const u32x4*)(X + (size_t)(m + ngw) * D))[64 + lane]; }
        s = wave_sum(s);
        const float rstd = rsqrtf(s * (1.0f / 1024.0f) + EPS);
        float z[8];
#pragma unroll
        for (int c = 0; c < 8; ++c) { float d = 0.f;
#pragma unroll
            for (int j = 0; j < 2; ++j) { const f32x4 w0 = *(const LAS f32x4*)(gwl + c * 1024 + 512 * j + 8 * lane), w1 = *(const LAS f32x4*)(gwl + c * 1024 + 512 * j + 8 * lane + 4);
                d += (v[j][0] * w0.x + v[j][1] * w0.y) + (v[j][2] * w0.z + v[j][3] * w0.w) + (v[j][4] * w1.x + v[j][5] * w1.y) + (v[j][6] * w1.z + v[j][7] * w1.w); }
            z[c] = wave_sum(d) * rstd; }
        float zc = z[0];
#pragma unroll
        for (int c = 1; c < 8; ++c) zc = lane == c ? z[c] : zc;
        const int b = m >> 12, tt = m & 4095;
        if (lane < 4) gate[(size_t)(b * 4 + lane) * SEQ + tt] = zc + A.in[16][lane];
        else if (lane < 8) gate[(size_t)(16 + b * 4 + lane - 4) * SEQ + tt] = log_sigmoid(zc + A.in[17][lane - 4]);
    }
    __syncthreads();
}

__device__ __forceinline__ void fox_unit(const Args& A, ldsp lds, LAS float* wscr, int bh, int qb) {
    unsigned char* ws = A.ws;
    const int b = bh >> 3, hd = bh & 7, tid_ = otid(), lane = tid_ & 63, wid = tid_ >> 6, n = lane & 31, h = lane >> 5;
    const bf16_t* P = (const bf16_t*)(ws + WS_R1);
    const size_t PS = (size_t)T * 512, ro = (size_t)b * SEQ * 512 + hd * 64;
    f32x16 o[2];
    flash_unit<64, 64, 1>(lds, wscr, P + ro, 512, P + PS + ro, 512, P + 2 * PS + ro, 512, (const float*)(ws + WS_GATE) + (size_t)bh * SEQ, qb * 256, qb * 4 + 4, o);
    bf16_t* mixed = (bf16_t*)(ws + WS_R2);
    const int qw = qb * 256 + 32 * wid;
#pragma unroll
    for (int db = 0; db < 2; ++db)
#pragma unroll
        for (int r = 0; r < 16; ++r) mixed[(size_t)(b * SEQ + qw + crow(r, h)) * D + hd * 64 + db * 32 + n] = f2bf(o[db][r]);
}
__device__ __forceinline__ void diff_unit(const Args& A, ldsp lds, LAS float* wscr, int bh, int qb) {
    unsigned char* ws = A.ws;
    const int b = bh >> 2, hd = bh & 3, tid_ = otid(), lane = tid_ & 63, wid = tid_ >> 6, n = lane & 31, h = lane >> 5;
    const bf16_t* P = (const bf16_t*)(ws + WS_R1);
    const size_t PS = (size_t)T * 512, ro = (size_t)b * SEQ * 512 + hd * 128;
    const float lam = ((const float*)(ws + WS_MISC))[0];
    f32x16 o[4];
    flash_unit<64, 128, 2>(lds, wscr, P + 3 * PS + ro, 512, P + 4 * PS + ro, 512, P + 5 * PS + ro, 512, nullptr, qb * 256, qb * 4 + 4, o);
    LAS unsigned* o1s = (LAS unsigned*)(lds + 60416 + wid * 8192) + lane;
#pragma unroll
    for (int db = 0; db < 4; ++db)
#pragma unroll
        for (int r = 0; r < 8; ++r) o1s[(db * 8 + r) * 64] = cvtpk(o[db][2 * r], o[db][2 * r + 1]);
    flash_unit<64, 128, 2>(lds, wscr, P + 3 * PS + ro + 64, 512, P + 4 * PS + ro + 64, 512, P + 5 * PS + ro, 512, nullptr, qb * 256, qb * 4 + 4, o);
    float ss[16];
#pragma unroll
    for (int r = 0; r < 16; ++r) ss[r] = 0.f;
#pragma unroll
    for (int db = 0; db < 4; ++db)
#pragma unroll
        for (int r = 0; r < 8; ++r) { const unsigned o1v = o1s[(db * 8 + r) * 64]; const float d0 = bflo(o1v) - lam * o[db][2 * r], d1 = bfhi(o1v) - lam * o[db][2 * r + 1]; o[db][2 * r] = d0; o[db][2 * r + 1] = d1; ss[2 * r] += d0 * d0; ss[2 * r + 1] += d1 * d1; }
#pragma unroll
    for (int r = 0; r < 16; ++r) {
#pragma unroll
        for (int x = 1; x < 32; x <<= 1) ss[r] += __shfl_xor(ss[r], x);
        ss[r] = rsqrtf(ss[r] * (1.0f / 128.0f) + EPS) * 0.8f; }
    bf16_t* mixed = (bf16_t*)(ws + WS_R2);
    const int qw = qb * 256 + 32 * wid;
#pragma unroll
    for (int db = 0; db < 4; ++db) { const float g = A.in[12][db * 32 + n];
#pragma unroll
        for (int r = 0; r < 16; ++r) mixed[(size_t)(b * SEQ + qw + crow(r, h)) * D + 512 + hd * 128 + db * 32 + n] = f2bf(o[db][r] * ss[r] * g); }
}
__device__ __forceinline__ void xattn_unit(const Args& A, ldsp lds, LAS float* wscr, int layer, int u) {
    unsigned char* ws = A.ws;
    const int dvh = u & 1, qb = (u >> 1) & 15, hd = (u >> 5) & 3, b = u >> 7, tid_ = otid(), lane = tid_ & 63, wid = tid_ >> 6, n = lane & 31, h = lane >> 5;
    const bf16_t* QX = (const bf16_t*)(ws + WS_R1) + (size_t)b * SEQ * D + hd * 256;
    const bf16_t* KV = (const bf16_t*)(ws + WS_KV) + (size_t)layer * MEMT * 2048 + (size_t)b * 256 * 2048 + hd * 256;
    f32x16 o[4];
    flash_unit<256, 128, 0>(lds, wscr, QX, D, KV, 2048, KV + 1024 + dvh * 128, 2048, nullptr, qb * 256, 4, o);
    bf16_t* xo = (bf16_t*)(ws + WS_R1 + 32 * MiB);
    const int qw = qb * 256 + 32 * wid;
#pragma unroll
    for (int db = 0; db < 4; ++db)
#pragma unroll
        for (int r = 0; r < 16; ++r) xo[(size_t)(b * SEQ + qw + crow(r, h)) * D + hd * 256 + dvh * 128 + db * 32 + n] = f2bf(o[db][r]);
}
__device__ __forceinline__ void xattn_unit2(const Args& A, ldsp lds, LAS float* wscr, int layer, int b, int hd, int qb) {
    constexpr int PK = 528, KBY = 64 * PK, PV = 320, VBY = 64 * PV;
    unsigned char* ws = A.ws;
    const int tid = otid(), lane = tid & 63, wid = tid >> 6, n = lane & 31, h = lane >> 5, i16 = lane & 15, q4 = i16 >> 2, p4 = i16 & 3, blk = (lane >> 4) & 1;
    const int qw = qb * 256 + 32 * wid;
    const bf16_t* Q = (const bf16_t*)(ws + WS_R1) + (size_t)b * SEQ * D + hd * 256;
    const bf16_t* Kp = (const bf16_t*)(ws + WS_KV) + (size_t)layer * MEMT * 2048 + (size_t)b * 256 * 2048 + hd * 256;
    const bf16_t* Vp = Kp + 1024;
    bf16x8 qf[16];
#pragma unroll
    for (int st = 0; st < 16; ++st) qf[st] = *(const bf16x8*)(Q + (size_t)(qw + n) * D + 16 * st + 8 * h);
    u32x4 kr[4];
#pragma unroll
    for (int i = 0; i < 4; ++i) { const int cid = tid + 512 * i, row = cid >> 5, cc = cid & 31; kr[i] = *(const u32x4*)(Kp + (size_t)row * 2048 + cc * 8); }
#pragma unroll
    for (int i = 0; i < 4; ++i) { const int cid = tid + 512 * i, row = cid >> 5, cc = cid & 31; *(LAS u32x4*)(lds + row * PK + cc * 16) = kr[i]; }
    __syncthreads();
    f32x16 S[8];
#pragma unroll
    for (int j = 0; j < 4; ++j) {
        ldsp st = lds + (j & 1) * KBY;
        if (j < 3) {
#pragma unroll
            for (int i = 0; i < 4; ++i) { const int cid = tid + 512 * i, row = cid >> 5, cc = cid & 31; kr[i] = *(const u32x4*)(Kp + (size_t)(64 * (j + 1) + row) * 2048 + cc * 8); }
        }
#pragma unroll
        for (int r = 0; r < 16; ++r) { S[2 * j][r] = 0.f; S[2 * j + 1][r] = 0.f; }
        ldsp ka = st + n * PK + 16 * h;
#pragma unroll
        for (int s = 0; s < 16; ++s) {
            const bf16x8 a0 = *(const LAS bf16x8*)(ka + 32 * s), a1 = *(const LAS bf16x8*)(ka + 32 * PK + 32 * s);
            S[2 * j] = MFMA32(a0, qf[s], S[2 * j]); S[2 * j + 1] = MFMA32(a1, qf[s], S[2 * j + 1]);
        }
        if (j < 3) {
#pragma unroll
            for (int i = 0; i < 4; ++i) { const int cid = tid + 512 * i, row = cid >> 5, cc = cid & 31; *(LAS u32x4*)(lds + ((j + 1) & 1) * KBY + row * PK + cc * 16) = kr[i]; }
        }
        __syncthreads();
    }
    u32x4 vr[2];
#pragma unroll
    for (int i = 0; i < 2; ++i) { const int cid = tid + 512 * i, row = cid >> 4, cc = cid & 15; vr[i] = *(const u32x4*)(Vp + (size_t)row * 2048 + cc * 8); }
    float mx = S[0][0];
#pragma unroll
    for (int t = 0; t < 8; ++t)
#pragma unroll
        for (int r = 0; r < 16; ++r) mx = fmaxf(mx, S[t][r]);
    mx = fmaxf(mx, __shfl_xor(mx, 32));
    f32x2 rs2 = {0.f, 0.f};
    bf16x8 P[8][2];
#pragma unroll
    for (int t = 0; t < 8; ++t) {
#pragma unroll
        for (int r = 0; r < 16; r += 2) { const f32x2 a = (f32x2){S[t][r], S[t][r + 1]} - mx; const f32x2 e = {ex2(a.x), ex2(a.y)}; S[t][r] = e.x; S[t][r + 1] = e.y; rs2 = rs2 + e; }
        P[t][0] = pack8(S[t], 0); P[t][1] = pack8(S[t], 1);
    }
    float lsum = rs2.x + rs2.y; lsum += __shfl_xor(lsum, 32);
    wscr[n] = 1.0f / lsum;
    asm volatile("s_waitcnt lgkmcnt(0)" ::: "memory");
    f32x4 linv[4];
#pragma unroll
    for (int g = 0; g < 4; ++g) linv[g] = *(const LAS f32x4*)(wscr + 8 * g + 4 * h);
#pragma unroll
    for (int i = 0; i < 2; ++i) { const int cid = tid + 512 * i, row = cid >> 4, cc = cid & 15; *(LAS u32x4*)(lds + row * PV + cc * 16) = vr[i]; }
    __syncthreads();
    bf16_t* xo = (bf16_t*)(ws + WS_R1 + 32 * MiB);
    f32x16 o[4];
#pragma unroll
    for (int t = 0; t < 8; ++t) {
        const int j = t & 3, dvh = t >> 2;
        ldsp st = lds + (t & 1) * VBY;
        if (t < 7) {
#pragma unroll
            for (int i = 0; i < 2; ++i) { const int cid = tid + 512 * i, row = cid >> 4, cc = cid & 15; vr[i] = *(const u32x4*)(Vp + (size_t)(64 * ((t + 1) & 3) + row) * 2048 + ((t + 1) >> 2) * 128 + cc * 8); }
        }
        if (j == 0) {
#pragma unroll
            for (int db = 0; db < 4; ++db)
#pragma unroll
                for (int r = 0; r < 16; ++r) o[db][r] = 0.f;
        }
        ldsp vb = st + (4 * h + q4) * PV + blk * 32 + 8 * p4;
#pragma unroll
        for (int ks = 0; ks < 4; ++ks) {
            const bf16x8 pa = P[2 * j + (ks >> 1)][ks & 1];
#pragma unroll
            for (int db = 0; db < 4; ++db) { const bf16x8 bv = tr8(vb + (16 * ks) * PV + db * 64, 8 * PV); o[db] = MFMA32(pa, bv, o[db]); }
        }
        if (j == 3) {
#pragma unroll
            for (int db = 0; db < 4; ++db)
#pragma unroll
                for (int r = 0; r < 16; ++r) xo[(size_t)(b * SEQ + qw + crow(r, h)) * D + hd * 256 + dvh * 128 + db * 32 + n] = f2bf(o[db][r] * linv[r >> 2][r & 3]);
        }
        if (t < 7) {
#pragma unroll
            for (int i = 0; i < 2; ++i) { const int cid = tid + 512 * i, row = cid >> 4, cc = cid & 15; *(LAS u32x4*)(lds + ((t + 1) & 1) * VBY + row * PV + cc * 16) = vr[i]; }
        }
        __syncthreads();
    }
}
__device__ __forceinline__ int next_unit(unsigned* ctr, LAS int* bc) {
    __syncthreads();
    if (threadIdx.x == 0) bc[0] = (int)atomicAdd(ctr, 1u);
    __syncthreads();
    return bc[0];
}

__device__ __forceinline__ void ffn_fixup(const Args& A, int layer, int gt, int ngt) {
    unsigned char* ws = A.ws;
    const float* head = (const float*)(ws + WS_R2); const float* tail = head + (size_t)512 * NUP;
    bf16_t* act = (bf16_t*)(ws + WS_R1);
    const float* cw = A.in[24] + (size_t)layer * 3 * NUP; const float* cb = A.in[25] + (size_t)layer * NUP;
    for (int it = gt; it < 256 * 2 * (DFF / 4); it += ngt) {
        const int j = (it % (DFF / 4)) * 4, rr = (it / (DFF / 4)) & 1, G = it / (DFF / 2);
        const bool first = (G & 63) == 0;
        f32x4 hv[2];
#pragma unroll
        for (int part = 0; part < 2; ++part) {
            const int c = part * DFF + j;
            const f32x4 z = {0.f, 0.f, 0.f, 0.f};
            const f32x4 pm2 = first ? z : *(const f32x4*)(tail + (size_t)((G - 1) * 2 + 0) * NUP + c), pm1 = first ? z : *(const f32x4*)(tail + (size_t)((G - 1) * 2 + 1) * NUP + c);
            const f32x4 p0 = *(const f32x4*)(head + (size_t)(G * 2 + 0) * NUP + c), p1 = *(const f32x4*)(head + (size_t)(G * 2 + 1) * NUP + c);
            const f32x4 w0 = *(const f32x4*)(cw + c), w1 = *(const f32x4*)(cw + NUP + c), w2 = *(const f32x4*)(cw + 2 * NUP + c), bb = *(const f32x4*)(cb + c);
            hv[part] = rr == 0 ? (w0 * pm2 + w1 * pm1 + w2 * p0 + bb) : (w0 * pm1 + w1 * p0 + w2 * p1 + bb);
        }
        u32x2 w; w.x = cvtpk(gelu_tanh(hv[0][0]) * hv[1][0], gelu_tanh(hv[0][1]) * hv[1][1]); w.y = cvtpk(gelu_tanh(hv[0][2]) * hv[1][2], gelu_tanh(hv[0][3]) * hv[1][3]);
        *(u32x2*)(act + (size_t)(G * 64 + rr) * DFF + j) = w;
    }
}

__device__ __forceinline__ void mlstm_conv(const Args& A, int gt, int ngt) {
    unsigned char* ws = A.ws;
    const bf16_t* src = (const bf16_t*)(ws + WS_R1); bf16_t* dst = (bf16_t*)A.out;
    const float* cw = A.in[15];
    for (int it = gt; it < 128 * 1024; it += ngt) {
        const int c0 = (it & 127) * 8, rb = it >> 7, row0 = rb * 16, t0 = row0 & 4095;
        float w[4][8];
#pragma unroll
        for (int tap = 0; tap < 4; ++tap) { const f32x4 a = *(const f32x4*)(cw + tap * 1024 + c0), b = *(const f32x4*)(cw + tap * 1024 + c0 + 4);
            w[tap][0] = a.x; w[tap][1] = a.y; w[tap][2] = a.z; w[tap][3] = a.w; w[tap][4] = b.x; w[tap][5] = b.y; w[tap][6] = b.z; w[tap][7] = b.w; }
        const float qs = c0 < 512 ? 0.08838834764831845f : 1.0f;
        u32x4 x3 = {0, 0, 0, 0}, x2 = x3, x1 = x3;
        if (t0 > 0) { x3 = *(const u32x4*)(src + (size_t)(row0 - 3) * D + c0); x2 = *(const u32x4*)(src + (size_t)(row0 - 2) * D + c0); x1 = *(const u32x4*)(src + (size_t)(row0 - 1) * D + c0); }
#pragma unroll 4
        for (int r = 0; r < 16; ++r) {
            const u32x4 x0 = *(const u32x4*)(src + (size_t)(row0 + r) * D + c0);
            float y[8];
#pragma unroll
            for (int e = 0; e < 4; ++e) {
                y[2 * e] = w[0][2 * e] * bflo(x3[e]) + w[1][2 * e] * bflo(x2[e]) + w[2][2 * e] * bflo(x1[e]) + w[3][2 * e] * bflo(x0[e]);
                y[2 * e + 1] = w[0][2 * e + 1] * bfhi(x3[e]) + w[1][2 * e + 1] * bfhi(x2[e]) + w[2][2 * e + 1] * bfhi(x1[e]) + w[3][2 * e + 1] * bfhi(x0[e]);
            }
#pragma unroll
            for (int e = 0; e < 8; ++e) y[e] = y[e] * __builtin_amdgcn_rcpf(1.f + __expf(-y[e])) * qs;
            u32x4 o; o.x = cvtpk(y[0], y[1]); o.y = cvtpk(y[2], y[3]); o.z = cvtpk(y[4], y[5]); o.w = cvtpk(y[6], y[7]);
            *(u32x4*)(dst + (size_t)(row0 + r) * D + c0) = o;
            x3 = x2; x2 = x1; x1 = x0;
        }
    }
}
constexpr int ML_PK = 320, ML_PV = 576, ML_PQ = 272;
__device__ __forceinline__ void mlstm_state_unit(const Args& A, ldsp lds, int u) {
    unsigned char* ws = A.ws;
    const int tid = otid(), lane = tid & 63, wid = tid >> 6, n = lane & 31, h = lane >> 5, i16 = lane & 15, q4 = i16 >> 2, p4 = i16 & 3, blk = (lane >> 4) & 1;
    const int bh = u >> 6, c = u & 63, b = bh >> 2, hd = bh & 3, r0 = b * SEQ + c * 64;
    const float* gate = (const float*)(ws + WS_GATE);
    float* chs = (float*)(ws + WS_CH);
    ldsp kt = lds, vt = lds + 64 * ML_PK; LAS float* wk = (LAS float*)(lds + 64 * ML_PK + 64 * ML_PV);
    const bf16_t* kq = (const bf16_t*)A.out + (size_t)r0 * D + 512 + hd * 128;
    const bf16_t* vp = (const bf16_t*)(ws + WS_R1 + 32 * MiB) + (size_t)r0 * D + hd * 256;
    u32x4 kx[2], vx[4];
#pragma unroll
    for (int i = 0; i < 2; ++i) { const int cid = tid + 512 * i, row = cid >> 4, cc = cid & 15; kx[i] = *(const u32x4*)(kq + (size_t)row * D + cc * 8); }
#pragma unroll
    for (int i = 0; i < 4; ++i) { const int cid = tid + 512 * i, row = cid >> 5, cc = cid & 31; vx[i] = *(const u32x4*)(vp + (size_t)row * D + cc * 8); }
    if (tid < 64) {
        const float ic = gate[(size_t)bh * SEQ + c * 64 + tid], fc = gate[(size_t)(16 + bh) * SEQ + c * 64 + tid];
        float bs = fc;
#pragma unroll
        for (int o = 1; o < 64; o <<= 1) { const float x = __shfl_up(bs, o); if (lane >= o) bs += x; }
        const float g = __shfl(bs, 63), a = g - bs + ic;
        float ml = a;
#pragma unroll
        for (int o = 1; o < 64; o <<= 1) ml = fmaxf(ml, __shfl_xor(ml, o));
        wk[tid] = __expf(a - ml);
        if (tid == 0) { chs[u] = g; chs[1024 + u] = ml; }
    }
    __syncthreads();
#pragma unroll
    for (int i = 0; i < 2; ++i) { const int cid = tid + 512 * i, row = cid >> 4, cc = cid & 15; const u32x4 x = kx[i]; const float w = wk[row];
        u32x4 y; y.x = cvtpk(bflo(x.x) * w, bfhi(x.x) * w); y.y = cvtpk(bflo(x.y) * w, bfhi(x.y) * w); y.z = cvtpk(bflo(x.z) * w, bfhi(x.z) * w); y.w = cvtpk(bflo(x.w) * w, bfhi(x.w) * w);
        *(LAS u32x4*)(kt + row * ML_PK + cc * 16) = y; }
#pragma unroll
    for (int i = 0; i < 4; ++i) { const int cid = tid + 512 * i, row = cid >> 5, cc = cid & 31; *(LAS u32x4*)(vt + row * ML_PV + cc * 16) = vx[i]; }
    __syncthreads();
    {
        const int d = tid & 127, qr = tid >> 7; float s = 0.f;
#pragma unroll
        for (int r = 0; r < 16; ++r) s += bf2f(*(const LAS bf16_t*)(kt + (16 * qr + r) * ML_PK + d * 2));
        wk[64 + tid] = s;
    }
    const int ib = wid & 3, vh = wid >> 2;
    f32x16 acc[4];
#pragma unroll
    for (int db = 0; db < 4; ++db)
#pragma unroll
        for (int r = 0; r < 16; ++r) acc[db][r] = 0.f;
#pragma unroll
    for (int st = 0; st < 4; ++st) {
        const bf16x8 af = tr8(kt + (16 * st + 8 * h + q4) * ML_PK + ib * 64 + blk * 32 + 8 * p4, 4 * ML_PK);
#pragma unroll
        for (int db = 0; db < 4; ++db) { const bf16x8 bv = tr8(vt + (16 * st + 8 * h + q4) * ML_PV + (vh * 4 + db) * 64 + blk * 32 + 8 * p4, 4 * ML_PV); acc[db] = MFMA32(af, bv, acc[db]); }
    }
    bf16_t* Sst = (bf16_t*)(ws + WS_R2) + (size_t)u * 128 * 256;
#pragma unroll
    for (int db = 0; db < 4; ++db)
#pragma unroll
        for (int r = 0; r < 16; ++r) Sst[(size_t)(ib * 32 + crow(r, h)) * 256 + (vh * 4 + db) * 32 + n] = f2bf(acc[db][r]);
    __syncthreads();
    if (tid < 128) ((float*)(ws + WS_NST))[(size_t)u * 128 + tid] = (wk[64 + tid] + wk[192 + tid]) + (wk[320 + tid] + wk[448 + tid]);
    __syncthreads();
}
__device__ __forceinline__ void mlstm_scan(const Args& A, int gt, int ngt) {
    unsigned char* ws = A.ws;
    float* chs = (float*)(ws + WS_CH);
    for (int it = gt; it < 16 * 8192 + 2048; it += ngt) {
        const bool isn = it >= 16 * 8192;
        const int bh = isn ? (it - 16 * 8192) >> 7 : it >> 13, e = isn ? (it - 16 * 8192) & 127 : (it & 8191) * 4;
        float m = 0.f; float c0 = 0.f, c1 = 0.f, c2 = 0.f, c3 = 0.f;
        for (int cb = 0; cb < 64; cb += 8) {
            u32x2 xv[8]; float xn[8], gg[8], mm[8];
#pragma unroll
            for (int i = 0; i < 8; ++i) { const int u = bh * 64 + cb + i; gg[i] = chs[u]; mm[i] = chs[1024 + u];
                if (isn) xn[i] = *((const float*)(ws + WS_NST) + (size_t)u * 128 + e); else xv[i] = *(const u32x2*)((const bf16_t*)(ws + WS_R2) + (size_t)u * 32768 + e); }
#pragma unroll
            for (int i = 0; i < 8; ++i) {
                const int u = bh * 64 + cb + i;
                const float g = gg[i], ml = mm[i], mnew = fmaxf(g + m, ml), dec = __expf(g + m - mnew), sc = __expf(ml - mnew);
                if (isn) { *((float*)(ws + WS_NST) + (size_t)u * 128 + e) = c0; c0 = dec * c0 + sc * xn[i]; }
                else { u32x2 y; y.x = cvtpk(c0, c1); y.y = cvtpk(c2, c3); *(u32x2*)((bf16_t*)(ws + WS_R2) + (size_t)u * 32768 + e) = y;
                    c0 = dec * c0 + sc * bflo(xv[i].x); c1 = dec * c1 + sc * bfhi(xv[i].x); c2 = dec * c2 + sc * bflo(xv[i].y); c3 = dec * c3 + sc * bfhi(xv[i].y);
                    if (e == 0) chs[2048 + u] = m; }
                m = mnew;
            }
        }
    }
}
__device__ __forceinline__ void mlstm_out_unit(const Args& A, ldsp lds, int u, bool dummy = false) {
    unsigned char* ws = A.ws;
    const int tid = otid(), lane = tid & 63, wid = tid >> 6, n = lane & 31, h = lane >> 5, i16 = lane & 15, q4 = i16 >> 2, p4 = i16 & 3, blk = (lane >> 4) & 1;
    const int bh = u >> 6, c = u & 63, b = bh >> 2, hd = bh & 3, r0 = b * SEQ + c * 64;
    const float* gate = (const float*)(ws + WS_GATE); const float* chs = (const float*)(ws + WS_CH);
    ldsp qt = lds, kt = lds + 64 * ML_PQ, vt = lds + 2 * 64 * ML_PQ, ct = vt + 64 * ML_PV;
    LAS float* sc = (LAS float*)(ct + 64 * ML_PV);
    LAS float *bt = sc, *ib = sc + 64, *mt = sc + 128, *wi = sc + 192, *qn = sc + 256, *rinv = sc + 320, *nv = sc + 384, *hs = sc + 512;
    const float mc = chs[2048 + u];
    if (tid < 64) {
        const float ic = gate[(size_t)bh * SEQ + c * 64 + tid], fc = gate[(size_t)(16 + bh) * SEQ + c * 64 + tid];
        float bs = fc;
#pragma unroll
        for (int o = 1; o < 64; o <<= 1) { const float x = __shfl_up(bs, o); if (lane >= o) bs += x; }
        const float ibv = ic - bs; float pm = ibv;
#pragma unroll
        for (int o = 1; o < 64; o <<= 1) { const float x = __shfl_up(pm, o); if (lane >= o) pm = fmaxf(pm, x); }
        const float mtv = fmaxf(bs + mc, bs + pm);
        bt[tid] = bs; ib[tid] = ibv; mt[tid] = mtv; wi[tid] = __expf(bs + mc - mtv);
    }
    const bf16_t* qp = (const bf16_t*)A.out + (size_t)r0 * D + hd * 128;
    bf16_t* vp = (bf16_t*)(ws + WS_R1 + 32 * MiB) + (size_t)r0 * D + hd * 256;
    const bf16_t* Cs = (const bf16_t*)(ws + WS_R2) + (size_t)u * 32768;
#pragma unroll
    for (int i = 0; i < 2; ++i) { const int cid = tid + 512 * i, row = cid >> 4, cc = cid & 15;
        *(LAS u32x4*)(qt + row * ML_PQ + cc * 16) = *(const u32x4*)(qp + (size_t)row * D + cc * 8);
        *(LAS u32x4*)(kt + row * ML_PQ + cc * 16) = *(const u32x4*)(qp + (size_t)row * D + 512 + cc * 8); }
    u32x4 c2r[4];
#pragma unroll
    for (int i = 0; i < 4; ++i) { const int cid = tid + 512 * i, row = cid >> 5, cc = cid & 31;
        *(LAS u32x4*)(vt + row * ML_PV + cc * 16) = *(const u32x4*)(vp + (size_t)row * D + cc * 8);
        *(LAS u32x4*)(ct + row * ML_PV + cc * 16) = *(const u32x4*)(Cs + (size_t)row * 256 + cc * 8);
        c2r[i] = *(const u32x4*)(Cs + (size_t)(64 + row) * 256 + cc * 8); }
    if (tid < 128) nv[tid] = ((const float*)(ws + WS_NST))[(size_t)u * 128 + tid];
    const int tb = wid & 1, eq = wid >> 1, t = 32 * tb + n;
    const bf16_t* og = (const bf16_t*)(ws + WS_R1 + 64 * MiB);
    const float* hn = A.in[18];
    bf16_t ogr[16][2]; float hnr[2];
#pragma unroll
    for (int eb = 0; eb < 2; ++eb) { const int col = hd * 256 + eq * 64 + eb * 32 + n; hnr[eb] = hn[col];
#pragma unroll
        for (int r = 0; r < 16; ++r) ogr[r][eb] = og[(size_t)(r0 + 32 * tb + crow(r, h)) * D + col]; }
    __syncthreads();
    {
        const int tq = tid >> 3, part = tid & 7;
        const u32x4 qa = *(const LAS u32x4*)(qt + tq * ML_PQ + part * 32), qb2 = *(const LAS u32x4*)(qt + tq * ML_PQ + part * 32 + 16);
        const LAS f32x4* nv4 = (const LAS f32x4*)(nv + part * 16);
        const f32x4 n0 = nv4[0], n1 = nv4[1], n2 = nv4[2], n3 = nv4[3];
        float s = bflo(qa.x) * n0.x + bfhi(qa.x) * n0.y + bflo(qa.y) * n0.z + bfhi(qa.y) * n0.w + bflo(qa.z) * n1.x + bfhi(qa.z) * n1.y + bflo(qa.w) * n1.z + bfhi(qa.w) * n1.w
                + bflo(qb2.x) * n2.x + bfhi(qb2.x) * n2.y + bflo(qb2.y) * n2.z + bfhi(qb2.y) * n2.w + bflo(qb2.z) * n3.x + bfhi(qb2.z) * n3.y + bflo(qb2.w) * n3.z + bfhi(qb2.w) * n3.w;
        s += __shfl_xor(s, 1); s += __shfl_xor(s, 2); s += __shfl_xor(s, 4);
        if (part == 0) qn[tq] = s;
    }
    f32x16 p[2];
#pragma unroll
    for (int sh = 0; sh < 2; ++sh) {
#pragma unroll
        for (int r = 0; r < 16; ++r) p[sh][r] = 0.f;
#pragma unroll
        for (int st = 0; st < 8; ++st) {
            const bf16x8 a = *(const LAS bf16x8*)(kt + (32 * sh + n) * ML_PQ + (16 * st + 8 * h) * 2), bq = *(const LAS bf16x8*)(qt + t * ML_PQ + (16 * st + 8 * h) * 2);
            p[sh] = MFMA32(a, bq, p[sh]);
        }
    }
    const float btl = bt[t], mtl = mt[t];
    float dsum = 0.f;
#pragma unroll
    for (int sh = 0; sh < 2; ++sh)
#pragma unroll
        for (int g = 0; g < 4; ++g) { const f32x4 iv = *(const LAS f32x4*)(ib + 32 * sh + 8 * g + 4 * h);
#pragma unroll
            for (int e = 0; e < 4; ++e) { const int s = 32 * sh + 8 * g + 4 * h + e; const float w = s <= t ? ex2((btl - mtl + iv[e]) * LOG2E) : 0.f; const float v = p[sh][4 * g + e] * w; p[sh][4 * g + e] = v; dsum += v; } }
    dsum += __shfl_xor(dsum, 32);
    __syncthreads();
    if (eq == 0 && h == 0) { const float den = wi[t] * qn[t] + dsum; rinv[t] = 1.0f / fmaxf(fabsf(den), __expf(-mtl)); }
    f32x16 acc[2];
#pragma unroll
    for (int eb = 0; eb < 2; ++eb)
#pragma unroll
        for (int r = 0; r < 16; ++r) acc[eb][r] = 0.f;
#pragma unroll
    for (int hc = 0; hc < 2; ++hc) {
        if (hc == 1) {
            __syncthreads();
#pragma unroll
            for (int i = 0; i < 4; ++i) { const int cid = tid + 512 * i, row = cid >> 5, cc = cid & 31; *(LAS u32x4*)(ct + row * ML_PV + cc * 16) = c2r[i]; }
            __syncthreads();
        }
#pragma unroll
        for (int st = 0; st < 4; ++st) {
            const bf16x8 a = *(const LAS bf16x8*)(qt + t * ML_PQ + (64 * hc + 16 * st + 8 * h) * 2);
#pragma unroll
            for (int eb = 0; eb < 2; ++eb) { const bf16x8 bv = tr8(ct + (16 * st + 8 * h + q4) * ML_PV + (eq * 2 + eb) * 64 + blk * 32 + 8 * p4, 4 * ML_PV); acc[eb] = MFMA32(a, bv, acc[eb]); }
        }
    }
#pragma unroll
    for (int g = 0; g < 4; ++g) { const f32x4 w4 = *(const LAS f32x4*)(wi + 32 * tb + 8 * g + 4 * h);
#pragma unroll
        for (int eb = 0; eb < 2; ++eb)
#pragma unroll
            for (int e = 0; e < 4; ++e) acc[eb][4 * g + e] *= w4[e]; }
#pragma unroll
    for (int ks = 0; ks < 4; ++ks) {
        const bf16x8 pa = (ks & 2) ? pack8(p[1], ks & 1) : pack8(p[0], ks & 1);
#pragma unroll
        for (int eb = 0; eb < 2; ++eb) { const bf16x8 bv = tr8(vt + (16 * ks + 4 * h + q4) * ML_PV + (eq * 2 + eb) * 64 + blk * 32 + 8 * p4, 8 * ML_PV); acc[eb] = MFMA32(pa, bv, acc[eb]); }
    }
    float ss[16];
#pragma unroll
    for (int g = 0; g < 4; ++g) { const f32x4 r4 = *(const LAS f32x4*)(rinv + 32 * tb + 8 * g + 4 * h);
#pragma unroll
        for (int e = 0; e < 4; ++e) { const int r = 4 * g + e; acc[0][r] *= r4[e]; acc[1][r] *= r4[e]; ss[r] = acc[0][r] * acc[0][r] + acc[1][r] * acc[1][r]; } }
#pragma unroll
    for (int r = 0; r < 16; ++r) {
#pragma unroll
        for (int x = 1; x < 32; x <<= 1) ss[r] += __shfl_xor(ss[r], x);
        if (n == 0) hs[(tb * 4 + eq) * 32 + crow(r, h)] = ss[r]; }
    __syncthreads();
#pragma unroll
    for (int r = 0; r < 16; ++r) {
        const int tr = crow(r, h);
        const float tot = hs[(tb * 4 + 0) * 32 + tr] + hs[(tb * 4 + 1) * 32 + tr] + hs[(tb * 4 + 2) * 32 + tr] + hs[(tb * 4 + 3) * 32 + tr];
        const float rstd = rsqrtf(tot * (1.0f / 256.0f) + EPS);
#pragma unroll
        for (int eb = 0; eb < 2; ++eb) {
            const int col = hd * 256 + eq * 64 + eb * 32 + n; const size_t off = (size_t)(r0 + 32 * tb + tr) * D + col;
            const float ogv = bf2f(ogr[r][eb]);
            (dummy ? (bf16_t*)(ws + 240 * MiB) + (off & 0x7fffff) : (bf16_t*)(ws + WS_R1 + 32 * MiB) + off)[0] = f2bf(acc[eb][r] * rstd * hnr[eb] * __builtin_amdgcn_rcpf(1.f + __expf(-ogv)));
        }
    }
    __syncthreads();
}

#ifndef PR_WQ
#define PR_WQ 0
#endif
#ifndef PR_RC
#define PR_RC 0
#endif
#ifndef PR_MOUT
#define PR_MOUT 0
#endif
#ifndef PR_SYNC
#define PR_SYNC 0
#endif
#ifndef PR_ATT
#define PR_ATT 0
#endif
#ifndef PR_XATT
#define PR_XATT 0
#endif
#ifndef PR_P0
#define PR_P0 0
#endif
#ifndef PR_MST
#define PR_MST 0
#endif
#ifndef PR_INP
#define PR_INP 0
#endif
#ifndef PR_UP
#define PR_UP 0
#endif
#ifndef PR_CONV
#define PR_CONV 0
#endif
__device__ __forceinline__ int static_unit(int nM, int nN, int G, int c, int i) {
    const int nwg = nM * nN; const long L = (long)i * G + c; if (L >= nwg) return -1;
    int wgid = (int)L; { const int q = nwg / 8, r = nwg % 8, xcd = wgid % 8, off = wgid / 8; wgid = (xcd < r ? xcd * (q + 1) : r * (q + 1) + (xcd - r) * q) + off; }
    const int nig = 8 * nN, gid = wgid / nig, fm = gid * 8, gsz = (nM - fm) < 8 ? (nM - fm) : 8;
    return ((fm + ((wgid % nig) % gsz)) << 8) | ((wgid % nig) / gsz);
}
struct OneUnit { int pm, pn;
    __device__ __forceinline__ bool next(int i, pg8::Unit& u) const { if (i) return false; u.pm = pm; u.pn = pn; return true; }
    __device__ __forceinline__ void a_ready(const pg8::Unit&) const {}
    __device__ __forceinline__ void done(const pg8::Unit&) const {} };
#define GEMM_CALL(EPI, g, S, E) pg8::gemm_phase<EPI, pg8::StaticOrder, true, true>(lds, g, S, E)
__global__ void __launch_bounds__(512, 2) mega_fwd(Args A) {
    extern __shared__ __attribute__((aligned(16))) unsigned char lds_raw[];
    ldsp lds = (ldsp)lds_raw;
    cg::grid_group grid = cg::this_grid();
    const int G = gridDim.x, bx = blockIdx.x, vcu = (G % 8 == 0) ? (bx % 8) * (G / 8) + bx / 8 : bx;
    const int ngw = G * 8, ngt = G * 512;
    unsigned char* ws = A.ws;
#define tid otid()
#define lane (otid() & 63)
#define wid __builtin_amdgcn_readfirstlane(otid() >> 6)
#define gw (vcu * 8 + __builtin_amdgcn_readfirstlane(otid() >> 6))
#define gt (bx * 512 + otid())
#define wscr ((LAS float*)(lds + LDS_X) + __builtin_amdgcn_readfirstlane(otid() >> 6) * 64)
    LAS int* bc = (LAS int*)(lds + LDS_X + 4096);
    unsigned* ctr = (unsigned*)(ws + WS_CTL);
    volatile LAS unsigned* xbst = (volatile LAS unsigned*)(lds + LDS_X + 12288);
    if (threadIdx.x < 4) xbst[threadIdx.x] = 0u;
    __syncthreads();
    const XcdBarrier xbar = xcd_barrier_post((unsigned*)(ws + WS_CTL + 4096), xbst);
#define GSYNC() xcd_barrier(xbar)
    bf16_t* xb = (bf16_t*)(ws + WS_XB); float* ssq = (float*)(ws + WS_SSQ);

    for (int rep = 0; rep <= PR_P0; ++rep) {
    for (int it = gw; it < WT_ITEMS; it += ngw) wt_dispatch(A, it, lds + wid * 8448, lane);
    __syncthreads();
    row_pass<0>(A, lds, A.in[0], A.in[6], 1536, A.in[2], gw, ngw, tid, lane);
    }
    for (int m = gw; m < MEMT; m += ngw) {
        const f32x4* xr = (const f32x4*)(A.in[1] + (size_t)m * D) + lane; f32x4 v[4]; float s = 0.f;
#pragma unroll
        for (int j = 0; j < 4; ++j) { v[j] = xr[64 * j]; s += (v[j].x * v[j].x + v[j].y * v[j].y) + (v[j].z * v[j].z + v[j].w * v[j].w); }
        s = wave_sum(s);
        u32x2* o8 = (u32x2*)((bf16_t*)(ws + WS_MEMB) + (size_t)m * D) + lane;
#pragma unroll
        for (int j = 0; j < 4; ++j) { u32x2 w; w.x = cvtpk(v[j].x, v[j].y); w.y = cvtpk(v[j].z, v[j].w); o8[64 * j] = w; }
        if (lane < 16) ((float*)(ws + WS_SSQM))[(size_t)m * 16 + lane] = lane == 0 ? s : 0.f;
    }
    for (int it = gt; it < DFF; it += ngt) {
        const int l = it / (DFF / 2), j = (it % (DFF / 2)) * 2; const float* cw = A.in[24] + (size_t)l * 3 * NUP; const float* cb = A.in[25] + (size_t)l * NUP;
        f32x4* o = (f32x4*)((float*)(ws + WS_CWP) + (size_t)it * 16);
        o[0] = (f32x4){cw[j], cw[j + 1], cw[NUP + j], cw[NUP + j + 1]}; o[1] = (f32x4){cw[2 * NUP + j], cw[2 * NUP + j + 1], cb[j], cb[j + 1]};
        o[2] = (f32x4){cw[DFF + j], cw[DFF + j + 1], cw[NUP + DFF + j], cw[NUP + DFF + j + 1]}; o[3] = (f32x4){cw[2 * NUP + DFF + j], cw[2 * NUP + DFF + j + 1], cb[DFF + j], cb[DFF + j + 1]};
    }
    if (bx == 0 && wid == 0) {
        const float s1 = wave_sum(A.in[8][lane] * A.in[9][lane]), s2 = wave_sum(A.in[10][lane] * A.in[11][lane]);
        if (lane == 0) ((float*)(ws + WS_MISC))[0] = __expf(s1) - __expf(s2) + 0.2f;
    }
    if (G == 0x7fffffff) grid.sync();
    GSYNC();
    for (int rep = 0; rep < PR_SYNC; ++rep) GSYNC();

#pragma clang loop unroll(disable)
    for (int layer = 0; layer < 2; ++layer) {
        if (layer == 0 && bx < 32) seq_cumsum((float*)(ws + WS_GATE) + (size_t)bx * SEQ, LOG2E, (LAS float*)(lds + LDS_X + 8192), tid, lane, wid);
        {
            pg8::Gemm g{xb, (const bf16_t*)(ws + (layer == 0 ? WS_WIN0 : WS_WIN1)), T, 3072, 1024}; pg8::StaticOrder S; S.init(T, 3072, G, bx);
            EpiScaledT E{(bf16_t*)(ws + WS_R1), layer == 0 ? 512 : 1024, layer == 0 ? (size_t)T * 512 : (size_t)T * 1024, layer == 0 ? 512 : 1024, (const LAS float*)(lds + LDS_RSTAB), 0.125f * LOG2E, layer == 0 ? 9u : 0u};
            rstab_fill(lds, S, ssq);
#pragma clang loop unroll(disable)
            for (int rep = 0; rep <= PR_INP; ++rep) { E.ord = 0; GEMM_CALL(EpiScaledT, g, S, E); }
        }
        GSYNC();
        if (layer == 0) {
#pragma clang loop unroll(disable)
            for (int rep = 0; rep <= PR_ATT; ++rep)
            for (;;) {
                const int uq = next_unit(ctr + 8 * rep, bc); if (uq >= 768 + 64) break;
                if (uq < 64) {
                    const int l = uq >> 5;
                    pg8::Gemm g{(const bf16_t*)(ws + WS_MEMB), (const bf16_t*)(ws + WS_WKV) + (size_t)l * 2048 * 1024, MEMT, 2048, 1024}; OneUnit S{(uq >> 3) & 3, uq & 7};
                    EpiScaled E{(bf16_t*)(ws + WS_KV) + (size_t)l * MEMT * 2048, 2048, 0, 2048, (const float*)(ws + WS_SSQM), 1.f, 0u};
                    pg8::gemm_phase<EpiScaled, OneUnit, false, true>(lds, g, S, E);
                    continue;
                }
                const int u = uq - 64;
                const int qb = 15 - u / 48, r = u % 48;
                if (r < 16) diff_unit(A, lds, wscr, r, qb); else fox_unit(A, lds, wscr, r - 16, qb);
            }
            GSYNC();
        } else {
            for (int rep = 0; rep <= PR_RC; ++rep) {
            row_gates_b(A, lds, xb, A.in[14], 2048, A.in[2] + 1024, gw, ngw, tid, lane);
            mlstm_conv(A, gt, ngt);
            }
            GSYNC();
#pragma clang loop unroll(disable)
            for (int rep = 0; rep <= PR_MST; ++rep)
            for (int u = bx; u < 1024; u += G) mlstm_state_unit(A, lds, u);
            GSYNC();
            mlstm_scan(A, gt, ngt);
            GSYNC();
            for (int rep = 0; rep < PR_MOUT; ++rep) for (int u = bx; u < 1024; u += G) mlstm_out_unit(A, lds, u, true);
            for (int u = bx; u < 1024; u += G) mlstm_out_unit(A, lds, u);
            GSYNC();
        }
        {
            pg8::Gemm g{(const bf16_t*)(ws + (layer == 0 ? WS_R2 : WS_R1 + 32 * MiB)), (const bf16_t*)(ws + (layer == 0 ? WS_WOUT0 : WS_WOUT1)), T, 1024, 1024}; pg8::StaticOrder S; S.init(T, 1024, G, bx);
            EpiRes E{layer == 0 ? A.in[0] : (const float*)nullptr, xb, ssq};
            GEMM_CALL(EpiRes, g, S, E);
        }
        GSYNC();
        {
            pg8::Gemm g{xb, (const bf16_t*)(ws + WS_WQ) + (size_t)layer * 1024 * 1024, T, 1024, 1024}; pg8::StaticOrder S; S.init(T, 1024, G, bx);
            EpiScaled E{(bf16_t*)(ws + WS_R1), 1024, 0, 1024, ssq, 0.0625f * LOG2E, 1u};
#pragma clang loop unroll(disable)
            for (int rep = 0; rep <= PR_WQ; ++rep) GEMM_CALL(EpiScaled, g, S, E);
            asm volatile("s_waitcnt vmcnt(0)" ::: "memory"); __syncthreads();
#pragma clang loop unroll(disable)
            for (int i = 0;; ++i) {
                const int uc = static_unit(T / 256, 4, G, bx, i); if (uc < 0) break;
                const int qpm = uc >> 8, qpn = uc & 255;
#pragma clang loop unroll(disable)
                for (int once = 0; once < 1; ++once) xattn_unit2(A, lds, wscr, layer, qpm >> 4, qpn, qpm & 15);
            }
        }
        GSYNC();
        {
            pg8::Gemm g{(const bf16_t*)(ws + WS_R1 + 32 * MiB), (const bf16_t*)(ws + WS_WO) + (size_t)layer * 1024 * 1024, T, 1024, 1024}; pg8::StaticOrder S; S.init(T, 1024, G, bx);
            EpiRes E{nullptr, xb, ssq};
            GEMM_CALL(EpiRes, g, S, E);
        }
        GSYNC();
        {
            pg8::Gemm g{xb, (const bf16_t*)(ws + WS_WUP) + (size_t)layer * NUP * 1024, T, NUP, 1024}; pg8::StaticOrder S; S.init(T, NUP, G, bx);
            EpiUp E{(bf16_t*)(ws + WS_R1), (float*)(ws + WS_R2), (float*)(ws + WS_R2) + (size_t)512 * NUP, ssq, (const float*)(ws + WS_CWP) + (size_t)layer * DFF * 8, (const LAS float*)(lds + LDS_RSTAB), (LAS float*)(lds + LDS_CWPS)};
            rstab_fill(lds, S, ssq);
#pragma clang loop unroll(disable)
            for (int rep = 0; rep <= PR_UP; ++rep) { E.ord = 0; GEMM_CALL(EpiUp, g, S, E); }
        }
        GSYNC();
        ffn_fixup(A, layer, gt, ngt);
        GSYNC();
        {
            pg8::Gemm g{(const bf16_t*)(ws + WS_R1), (const bf16_t*)(ws + WS_WDN) + (size_t)layer * 1024 * DFF, T, 1024, DFF}; pg8::StaticOrder S; S.init(T, 1024, G, bx);
            EpiRes E{nullptr, xb, ssq};
            GEMM_CALL(EpiRes, g, S, E);
        }
        GSYNC();
    }
    {
        u32x4 fnx[2];
        if (gw < T) { fnx[0] = ((const u32x4*)(xb + (size_t)gw * D))[lane]; fnx[1] = ((const u32x4*)(xb + (size_t)gw * D))[64 + lane]; }
        for (int m = gw; m < T; m += ngw) {
            float vv[2][8]; float s = 0.f;
#pragma unroll
            for (int j = 0; j < 2; ++j) { const u32x4 r = fnx[j];
                vv[j][0] = bflo(r.x); vv[j][1] = bfhi(r.x); vv[j][2] = bflo(r.y); vv[j][3] = bfhi(r.y); vv[j][4] = bflo(r.z); vv[j][5] = bfhi(r.z); vv[j][6] = bflo(r.w); vv[j][7] = bfhi(r.w);
#pragma unroll
                for (int e = 0; e < 8; ++e) s += vv[j][e] * vv[j][e]; }
            if (m + ngw < T) { fnx[0] = ((const u32x4*)(xb + (size_t)(m + ngw) * D))[lane]; fnx[1] = ((const u32x4*)(xb + (size_t)(m + ngw) * D))[64 + lane]; }
            const float rstd = rsqrtf(wave_sum(s) * (1.0f / 1024.0f) + EPS);
#pragma unroll
            for (int j = 0; j < 2; ++j) { const f32x4 g0 = *(const f32x4*)(A.in[27] + 512 * j + 8 * lane), g1 = *(const f32x4*)(A.in[27] + 512 * j + 8 * lane + 4);
                f32x4* o = (f32x4*)(A.out + (size_t)m * D + 512 * j + 8 * lane);
                o[0] = (f32x4){vv[j][0], vv[j][1], vv[j][2], vv[j][3]} * rstd * g0; o[1] = (f32x4){vv[j][4], vv[j][5], vv[j][6], vv[j][7]} * rstd * g1; }
        }
    }
#undef tid
#undef lane
#undef wid
#undef gw
#undef gt
#undef wscr
}

extern "C" void kernel_launch(void* const* d_in, const int* in_sizes, int n_in, void* d_out, int out_size, void* d_ws, size_t ws_size, hipStream_t stream) {
    static int grid = 0;
    if (grid == 0) {
        if (n_in != 28 || out_size != T * D || ws_size < WS_END) { fprintf(stderr, "kernel_launch: unexpected problem shape (n_in %d out %d ws %zu)\n", n_in, out_size, ws_size); grid = -1; return; }
        int dev = 0, cus = 0, per_cu = 0;
        if (hipGetDevice(&dev) != hipSuccess || hipDeviceGetAttribute(&cus, hipDeviceAttributeMultiprocessorCount, dev) != hipSuccess) { grid = -1; return; }
        if (hipFuncSetAttribute((const void*)mega_fwd, hipFuncAttributeMaxDynamicSharedMemorySize, LDS_BYTES) != hipSuccess) { fprintf(stderr, "kernel_launch: hipFuncSetAttribute failed\n"); grid = -1; return; }
        if (hipOccupancyMaxActiveBlocksPerMultiprocessor(&per_cu, (const void*)mega_fwd, 512, LDS_BYTES) != hipSuccess || per_cu < 1) { fprintf(stderr, "kernel_launch: occupancy query says %d blocks per CU\n", per_cu); (void)hipGetLastError(); per_cu = 1; }
        grid = cus;
        if (grid < 256) { fprintf(stderr, "kernel_launch: built for >= 256 CUs (got %d)\n", cus); grid = -1; return; }
    }
    if (grid < 0) return;
    (void)hipMemsetAsync((char*)d_ws + WS_CTL, 0, 32768, stream);
    Args a{};
    for (int i = 0; i < 28; ++i) a.in[i] = (const float*)d_in[i];
    a.out = (float*)d_out; a.ws = (unsigned char*)d_ws;
    void* args[] = {&a};
    hipError_t e = hipLaunchCooperativeKernel((const void*)mega_fwd, dim3(grid), dim3(512), args, LDS_BYTES, stream);
    if (e != hipSuccess) fprintf(stderr, "cooperative launch failed: %s (grid %d)\n", hipGetErrorString(e), grid);
}
```

```cpp
#include <hip/hip_runtime.h>
#include <hip/hip_cooperative_groups.h>
#include <cstdio>
#include <cstdint>
#include <cmath>
namespace cg = cooperative_groups;

namespace pg8 {
#define PG8_LAS __attribute__((address_space(3)))
typedef unsigned short bf16_t;
typedef short bf16x8 __attribute__((ext_vector_type(8)));
typedef float f32x4 __attribute__((ext_vector_type(4)));
typedef unsigned u32x4 __attribute__((ext_vector_type(4)));
constexpr int BM = 256, BK = 64, HALF = 128, HTB = HALF * BK * 2  , STAGE_BYTES = 8 * HTB, NXCD = 8, WGM = 8;

__host__ __device__ __forceinline__ int lds_byte(int r, int c) { const int st = (r >> 4) * 2 + (c >> 5), rr = r & 15, cc = c & 31, ob = rr * 64 + cc * 2; return st * 1024 + (ob ^ (((ob >> 9) & 1) << 5)); }
__host__ __device__ __forceinline__ void stage_rc(int b, int& R, int& C) { const int st = b / 1024, sb = b % 1024, swz = sb ^ (((sb >> 9) & 1) << 5); R = (st >> 1) * 16 + swz / 64; C = (st & 1) * 32 + (swz % 64) / 2; }
__host__ __device__ __forceinline__ int perm32(int rho) { const int n = rho >> 4, i = rho & 15; return 8 * (i >> 2) + 4 * n + (i & 3); }

struct Unit { int pm, pn; };
struct Gemm { const bf16_t* A; const bf16_t* Bt; int M, N, K; };

struct StaticOrder {
    int nM, nN, nwg, G, c;
    __host__ __device__ void init(int M, int N, int G_, int c_) { nM = M / BM; nN = N / BM; nwg = nM * nN; G = G_; c = c_; }
    __host__ __device__ bool next(int i, Unit& u) const {
        const long L = (long)i * G + c; if (L >= nwg) return false;
        int wgid = (int)L; { const int q = nwg / NXCD, r = nwg % NXCD, xcd = wgid % NXCD, off = wgid / NXCD; wgid = (xcd < r ? xcd * (q + 1) : r * (q + 1) + (xcd - r) * q) + off; }
        const int nig = WGM * nN, gid = wgid / nig, fm = gid * WGM, gsz = (nM - fm) < WGM ? (nM - fm) : WGM;
        u.pm = fm + ((wgid % nig) % gsz); u.pn = (wgid % nig) / gsz; return true;
    }
    __device__ __forceinline__ void a_ready(const Unit&) const {}
    __device__ __forceinline__ void done(const Unit&) const {}
};

__device__ __forceinline__ unsigned cvt_pk_bf16(float lo, float hi) { unsigned r; asm volatile("v_cvt_pk_bf16_f32 %0, %1, %2" : "=v"(r) : "v"(lo), "v"(hi)); return r; }
typedef float f32x2 __attribute__((ext_vector_type(2)));
__device__ __forceinline__ f32x2 gelu_pk(f32x2 v) {
    const f32x2 av = __builtin_elementwise_abs(v), d = av * 0.2316418882f + 1.0f;
    f32x2 t; t.x = __builtin_amdgcn_rcpf(d.x); t.y = __builtin_amdgcn_rcpf(d.y);
    f32x2 q = t * 0.5307027145f + (-0.7265760135f); q = q * t + 0.7107068705f; q = q * t + (-0.142248368f); q = q * t + 0.127414796f; q = q * t;
    const f32x2 s = (v * v) * (-0.72134752044f);
    f32x2 e; e.x = __builtin_amdgcn_exp2f(s.x); e.y = __builtin_amdgcn_exp2f(s.y);
    const f32x2 m = v * (q * e), r = v - m;
    f32x2 o; o.x = v.x < 0.f ? m.x : r.x; o.y = v.y < 0.f ? m.y : r.y; return o;
}

template <int ACT  > struct EpiBf16 {
    static constexpr bool PERM = true, AFTER_DRAIN = false; static_assert(ACT == 0 || ACT == 1, "EpiBf16: ACT is 0 (none) or 1 (gelu_pk)");
    bf16_t* O; int ldc; const float* bias; int split_cols; size_t split_stride; float scale0;
    __device__ __forceinline__ void operator()(const f32x4 (&acc)[2][2][4][2], const Unit& u, int wr, int wc, int fr, int fq) const {
        const int row0 = u.pm * BM + wr * 64 + fr; int colt = u.pn * BM; bf16_t* base = O;
        float sc = 1.f; if (split_cols) { const int t = colt / split_cols; base += (size_t)t * split_stride; colt -= t * split_cols; if (t == 0) sc = scale0; }
        const int col0 = colt + wc * 32 + 8 * fq, bcol0 = u.pn * BM + wc * 32 + 8 * fq;
        f32x4 bv[2][2];
#pragma unroll
        for (int bj = 0; bj < 2; ++bj)
#pragma unroll
            for (int n = 0; n < 2; ++n) bv[bj][n] = bias ? *(const f32x4*)(bias + bcol0 + bj * HALF + 4 * n) : (f32x4){0.f, 0.f, 0.f, 0.f};
#pragma unroll
        for (int ai = 0; ai < 2; ++ai)
#pragma unroll
            for (int m = 0; m < 4; ++m) { bf16_t* rowp = base + (size_t)(row0 + ai * HALF + m * 16) * ldc + col0;
#pragma unroll
                for (int bj = 0; bj < 2; ++bj) { f32x4 v0 = acc[ai][bj][m][0] + bv[bj][0], v1 = acc[ai][bj][m][1] + bv[bj][1];
                    if (ACT == 1) { f32x2 a = gelu_pk((f32x2){v0[0], v0[1]}), b = gelu_pk((f32x2){v0[2], v0[3]}), c = gelu_pk((f32x2){v1[0], v1[1]}), d = gelu_pk((f32x2){v1[2], v1[3]});
                        v0 = (f32x4){a.x, a.y, b.x, b.y}; v1 = (f32x4){c.x, c.y, d.x, d.y}; }
                    v0 = v0 * sc; v1 = v1 * sc; u32x4 w; w.x = cvt_pk_bf16(v0[0], v0[1]); w.y = cvt_pk_bf16(v0[2], v0[3]); w.z = cvt_pk_bf16(v1[0], v1[1]); w.w = cvt_pk_bf16(v1[2], v1[3]);
                    *(u32x4*)(rowp + bj * HALF) = w; } }
    }
};
template <class Epi> constexpr auto epi_aperm(int) -> decltype(Epi::APERM) { return Epi::APERM; }
template <class Epi> constexpr bool epi_aperm(long) { return false; }
template <class Epi, class Sched, bool ALIGN_EPI = false, bool SP2 = false>
__device__ __forceinline__ void gemm_phase(PG8_LAS unsigned char* lds, const Gemm g, const Sched& S, const Epi& E) {
    int tid_ = threadIdx.x; asm volatile("" : "+v"(tid_));
    const int tid = tid_, wid = __builtin_amdgcn_readfirstlane(tid >> 6), lane = tid & 63, wr = wid >> 2, wc = wid & 3, fr = lane & 15, fq = lane >> 4;
    const int K = g.K, nt = K / BK;
    unsigned voffA[2], voffB[2];
#pragma unroll
    for (int i = 0; i < 2; ++i) { int R, C; stage_rc(tid * 16 + i * 8192, R, C); const int Rb = Epi::PERM ? ((R & ~31) + perm32(R & 31)) : R;
        const int Ra = epi_aperm<Epi>(0) ? ((R & ~63) + 4 * (R & 15) + ((R >> 4) & 3)) : R;
        voffA[i] = (unsigned)(Ra * K + C) * 2u; voffB[i] = (unsigned)(Rb * K + C) * 2u; }
    const size_t kstep = (size_t)(BK * 2);
    const size_t hstep = (size_t)HALF * K * 2;
    const size_t tstep = 2 * hstep;
    const unsigned ldsw = (unsigned)wid * 1024u;
    const int aoff = lds_byte(wr * 64 + fr, fq * 8), boff = lds_byte(wc * 32 + fr, fq * 8);
#define PG8_SA(b, h) (((b) * 2 + (h)) * HTB)
#define PG8_SB(b, h) ((4 + (b) * 2 + (h)) * HTB)
#define PG8_STAGE(bufoff, gbase, voff) do { _Pragma("unroll") for (int _i = 0; _i < 2; ++_i) \
        __builtin_amdgcn_global_load_lds((const unsigned*)((const char*)(gbase) + (voff)[_i]), (PG8_LAS unsigned*)(lds + (bufoff) + ldsw + _i * 8192), 16, 0, 0); } while (0)
#define PG8_LDA(dst, b, h) do { _Pragma("unroll") for (int m = 0; m < 4; ++m) _Pragma("unroll") for (int k = 0; k < 2; ++k) dst[m][k] = *(const PG8_LAS bf16x8*)(lds + PG8_SA(b, h) + aoff + m * 2048 + k * 1024); } while (0)
#define PG8_LDB(dst, b, h) do { _Pragma("unroll") for (int n = 0; n < 2; ++n) _Pragma("unroll") for (int k = 0; k < 2; ++k) dst[n][k] = *(const PG8_LAS bf16x8*)(lds + PG8_SB(b, h) + boff + n * 2048 + k * 1024); } while (0)
#define PG8_MMA(ai, bj, At, Bt) do { __builtin_amdgcn_s_setprio(1); _Pragma("unroll") for (int m = 0; m < 4; ++m) _Pragma("unroll") for (int n = 0; n < 2; ++n) _Pragma("unroll") for (int k = 0; k < 2; ++k) \
        acc[ai][bj][m][n] = __builtin_amdgcn_mfma_f32_16x16x32_bf16(Bt[n][k], At[m][k], acc[ai][bj][m][n], 0, 0, 0); __builtin_amdgcn_s_setprio(0); } while (0)
#define PG8_WAIT_V(n) asm volatile("s_waitcnt vmcnt(" #n ")" ::: "memory")
#define PG8_WAIT_L(n) asm volatile("s_waitcnt lgkmcnt(" #n ")" ::: "memory")
#define PG8_BAR __builtin_amdgcn_s_barrier()
#define PG8_SCHED __builtin_amdgcn_sched_barrier(0)
    Unit cur, nxt; int ui = 0;
    if (!S.next(0, cur)) return;
    f32x4 acc[2][2][4][2];
#pragma unroll
    for (int a = 0; a < 2; ++a)
#pragma unroll
        for (int b = 0; b < 2; ++b)
#pragma unroll
            for (int m = 0; m < 4; ++m)
#pragma unroll
                for (int n = 0; n < 2; ++n) acc[a][b][m][n] = (f32x4){0.f, 0.f, 0.f, 0.f};
    bf16x8 At[4][2], B0[2][2], B1[2][2];
    const char* cA = (const char*)g.A + (size_t)cur.pm * tstep; const char* cB = (const char*)g.Bt + (size_t)cur.pn * tstep;
    S.a_ready(cur);
    if constexpr (SP2) {
        PG8_STAGE(PG8_SB(0, 0), cB, voffB); PG8_STAGE(PG8_SB(0, 1), cB + hstep, voffB); PG8_STAGE(PG8_SA(0, 0), cA, voffA); PG8_STAGE(PG8_SA(0, 1), cA + hstep, voffA);
        if (wr == 1) PG8_BAR;
        PG8_WAIT_V(2); PG8_BAR;
        PG8_STAGE(PG8_SB(1, 0), cB + kstep, voffB); PG8_STAGE(PG8_SA(1, 0), cA + kstep, voffA); PG8_STAGE(PG8_SB(1, 1), cB + hstep + kstep, voffB);
        PG8_WAIT_V(6); PG8_BAR;
    } else {
        PG8_STAGE(PG8_SB(0, 0), cB, voffB); PG8_STAGE(PG8_SA(0, 0), cA, voffA); PG8_STAGE(PG8_SB(0, 1), cB + hstep, voffB); PG8_STAGE(PG8_SA(0, 1), cA + hstep, voffA);
        if (wr == 1) PG8_BAR;
        PG8_WAIT_V(4); PG8_BAR;
        PG8_STAGE(PG8_SB(1, 0), cB + kstep, voffB); PG8_STAGE(PG8_SA(1, 0), cA + kstep, voffA); PG8_STAGE(PG8_SB(1, 1), cB + hstep + kstep, voffB);
        PG8_WAIT_V(6); PG8_BAR;
    }
    for (;;) {
        const bool has_next = S.next(ui + 1, nxt);
        const char* nA = has_next ? (const char*)g.A + (size_t)nxt.pm * tstep : cA; const char* nB = has_next ? (const char*)g.Bt + (size_t)nxt.pn * tstep : cB;
        for (int t = 0; t < nt; t += 2) {
            const bool last = (t == nt - 2);
            const char* a1 = cA + (size_t)(t + 1) * kstep;
            const char* a2 = last ? nA : cA + (size_t)(t + 2) * kstep; const char* b2 = last ? nB : cB + (size_t)(t + 2) * kstep;
            const char* a3 = a2 + kstep; const char* b3 = b2 + kstep;
            if (last && has_next) S.a_ready(nxt);
            if constexpr (SP2) {
            PG8_LDB(B0, 0, 0); PG8_LDB(B1, 0, 1); PG8_SCHED; PG8_LDA(At, 0, 0); PG8_STAGE(PG8_SA(1, 1), a1 + hstep, voffA);
            PG8_WAIT_V(8); PG8_WAIT_L(0); PG8_BAR; PG8_MMA(0, 0, At, B0); PG8_MMA(0, 1, At, B1); PG8_BAR; PG8_SCHED;
            PG8_LDA(At, 0, 1); PG8_STAGE(PG8_SB(0, 0), b2, voffB); PG8_STAGE(PG8_SB(0, 1), b2 + hstep, voffB); PG8_STAGE(PG8_SA(0, 0), a2, voffA);
            PG8_WAIT_V(8); PG8_WAIT_L(0); PG8_BAR; PG8_MMA(1, 0, At, B0); PG8_MMA(1, 1, At, B1); PG8_BAR; PG8_SCHED;
            PG8_LDB(B0, 1, 0); PG8_LDB(B1, 1, 1); PG8_SCHED; PG8_LDA(At, 1, 0); PG8_STAGE(PG8_SA(0, 1), a2 + hstep, voffA);
            PG8_WAIT_V(8); PG8_WAIT_L(0); PG8_BAR; PG8_MMA(0, 0, At, B0); PG8_MMA(0, 1, At, B1); PG8_BAR; PG8_SCHED;
            PG8_LDA(At, 1, 1); PG8_STAGE(PG8_SB(1, 0), b3, voffB); PG8_STAGE(PG8_SB(1, 1), b3 + hstep, voffB); PG8_STAGE(PG8_SA(1, 0), a3, voffA);
            PG8_WAIT_V(8); PG8_WAIT_L(0); PG8_BAR; PG8_MMA(1, 0, At, B0); PG8_MMA(1, 1, At, B1); PG8_BAR; PG8_SCHED;
            } else {
            PG8_LDB(B0, 0, 0); PG8_SCHED; PG8_LDA(At, 0, 0); PG8_STAGE(PG8_SA(1, 1), a1 + hstep, voffA);
            PG8_WAIT_L(8); PG8_BAR; PG8_WAIT_L(0); PG8_MMA(0, 0, At, B0); PG8_BAR; PG8_SCHED;
            PG8_LDB(B1, 0, 1); PG8_STAGE(PG8_SB(0, 0), b2, voffB);
            PG8_BAR; PG8_WAIT_L(0); PG8_MMA(0, 1, At, B1); PG8_BAR;
            PG8_LDA(At, 0, 1); PG8_STAGE(PG8_SA(0, 0), a2, voffA);
            PG8_BAR; PG8_WAIT_L(0); PG8_MMA(1, 0, At, B0); PG8_BAR; PG8_SCHED;
            PG8_STAGE(PG8_SB(0, 1), b2 + hstep, voffB);
            PG8_WAIT_V(6); PG8_BAR; PG8_MMA(1, 1, At, B1); PG8_BAR;
            PG8_LDB(B0, 1, 0); PG8_SCHED; PG8_LDA(At, 1, 0); PG8_STAGE(PG8_SA(0, 1), a2 + hstep, voffA);
            PG8_WAIT_L(8); PG8_BAR; PG8_WAIT_L(0); PG8_MMA(0, 0, At, B0); PG8_BAR; PG8_SCHED;
            PG8_LDB(B1, 1, 1); PG8_STAGE(PG8_SB(1, 0), b3, voffB);
            PG8_BAR; PG8_WAIT_L(0); PG8_MMA(0, 1, At, B1); PG8_BAR;
            PG8_LDA(At, 1, 1); PG8_STAGE(PG8_SA(1, 0), a3, voffA);
            PG8_BAR; PG8_WAIT_L(0); PG8_MMA(1, 0, At, B0); PG8_BAR; PG8_SCHED;
            PG8_STAGE(PG8_SB(1, 1), b3 + hstep, voffB);
            PG8_WAIT_V(6); PG8_BAR; PG8_MMA(1, 1, At, B1); PG8_BAR;
            }
        }
        if constexpr (ALIGN_EPI) { if (wr == 0) PG8_BAR; }
        if constexpr (!Epi::AFTER_DRAIN) { E(acc, cur, wr, wc, fr, fq); S.done(cur); }
        if (!has_next) break;
#pragma unroll
        for (int a = 0; a < 2; ++a)
#pragma unroll
            for (int b = 0; b < 2; ++b)
#pragma unroll
                for (int m = 0; m < 4; ++m)
#pragma unroll
                    for (int n = 0; n < 2; ++n) acc[a][b][m][n] = (f32x4){0.f, 0.f, 0.f, 0.f};
        cur = nxt; cA = nA; cB = nB; ++ui;
        if constexpr (ALIGN_EPI) { if (wr == 1) PG8_BAR; }
    }
    PG8_WAIT_V(0);
    if constexpr (!ALIGN_EPI) { if (wr == 0) PG8_BAR; }
    PG8_BAR;
    if constexpr (Epi::AFTER_DRAIN) { E.fused(acc, cur, wr, wc, fr, fq, lds, wid, lane); S.done(cur); }
#undef PG8_SA
#undef PG8_SB
#undef PG8_STAGE
#undef PG8_LDA
#undef PG8_LDB
#undef PG8_MMA
#undef PG8_WAIT_V
#undef PG8_WAIT_L
#undef PG8_BAR
#undef PG8_SCHED
}
}

#ifndef PG8_SP2
#define PG8_SP2 true
#endif
#ifndef PG8_ALIGN
#define PG8_ALIGN true
#endif

#define LAS __attribute__((address_space(3)))
typedef unsigned short bf16_t;
typedef short bf16x8 __attribute__((ext_vector_type(8)));
typedef short s16x4 __attribute__((ext_vector_type(4)));
typedef float f32x4 __attribute__((ext_vector_type(4)));
typedef float f32x2 __attribute__((ext_vector_type(2)));
typedef float f32x16 __attribute__((ext_vector_type(16)));
typedef unsigned u32x4 __attribute__((ext_vector_type(4)));
typedef unsigned u32x2 __attribute__((ext_vector_type(2)));
typedef __bf16 bf16x2_t __attribute__((ext_vector_type(2)));
typedef LAS unsigned char* ldsp;

constexpr int T = 16384, SEQ = 4096, NB = 4, D = 1024, DFF = 2816, NUP = 5632, MEMT = 1024;
constexpr float EPS = 1e-6f, LOG2E = 1.4426950408889634f;
constexpr size_t MiB = 1u << 20;
constexpr size_t WS_CTL = 0, WS_MISC = 65536;
constexpr size_t WS_WIN0 = 1 * MiB, WS_WOUT0 = 7 * MiB, WS_WQ = 9 * MiB, WS_WKV = 13 * MiB, WS_WO = 21 * MiB, WS_WUP = 25 * MiB, WS_WDN = 47 * MiB, WS_WIN1 = 58 * MiB, WS_WOUT1 = 64 * MiB;
constexpr size_t WS_SSQ = 66 * MiB, WS_SSQM = 67 * MiB, WS_GATE = 68 * MiB, WS_MEMB = 69 * MiB, WS_KV = 71 * MiB, WS_CH = 79 * MiB, WS_NST = 79 * MiB + 512 * 1024;
constexpr size_t WS_XB = 80 * MiB, WS_R2 = 112 * MiB, WS_R1 = 144 * MiB, WS_END = 240 * MiB;
constexpr size_t WS_CWP = 79 * MiB + 64 * 1024;
constexpr int LDS_BYTES = 159744, LDS_X = 131072, LDS_RSTAB = LDS_X + 12544, LDS_CWPS = LDS_X + 18688;

__device__ __forceinline__ unsigned cvtpk(float lo, float hi) { f32x2 v = {lo, hi}; bf16x2_t b = __builtin_convertvector(v, bf16x2_t); return __builtin_bit_cast(unsigned, b); }
__device__ __forceinline__ float bflo(unsigned u) { return __uint_as_float(u << 16); }
__device__ __forceinline__ float bfhi(unsigned u) { return __uint_as_float(u & 0xffff0000u); }
__device__ __forceinline__ float bf2f(bf16_t v) { return __uint_as_float(((unsigned)v) << 16); }
__device__ __forceinline__ bf16_t f2bf(float f) { return (bf16_t)(cvtpk(f, 0.f) & 0xffffu); }
__device__ __forceinline__ float wave_sum(float v) {
#pragma unroll
    for (int o = 1; o < 64; o <<= 1) v += __shfl_xor(v, o);
    return v;
}
__device__ __forceinline__ float ex2(float x) { return __builtin_amdgcn_exp2f(x); }
__device__ __forceinline__ float log_sigmoid(float z) { return fminf(z, 0.f) - __logf(1.f + __expf(-fabsf(z))); }
__device__ __forceinline__ float ror1(float v) { return __builtin_bit_cast(float, __builtin_amdgcn_update_dpp(0, __builtin_bit_cast(int, v), 0x121, 0xf, 0xf, false)); }
__device__ __forceinline__ float ror2(float v) { return __builtin_bit_cast(float, __builtin_amdgcn_update_dpp(0, __builtin_bit_cast(int, v), 0x122, 0xf, 0xf, false)); }
__device__ __forceinline__ float gelu_tanh(float x) { return x * __builtin_amdgcn_rcpf(1.f + ex2(-2.302208198f * (x + 0.044715f * x * x * x))); }
__device__ __forceinline__ int crow(int r, int h) { return (r & 3) + 8 * (r >> 2) + 4 * h; }
typedef short v4i16_t __attribute__((ext_vector_type(4)));
__device__ __forceinline__ bf16x8 tr8(ldsp p, int hi_off) {
    s16x4 lo = __builtin_bit_cast(s16x4, __builtin_amdgcn_ds_read_tr16_b64_v4i16((LAS v4i16_t*)p));
    s16x4 hi = __builtin_bit_cast(s16x4, __builtin_amdgcn_ds_read_tr16_b64_v4i16((LAS v4i16_t*)(p + hi_off)));
    return __builtin_shufflevector(lo, hi, 0, 1, 2, 3, 4, 5, 6, 7);
}
__device__ __forceinline__ bf16x8 pack8(const f32x16& x, int s) {
    u32x4 p; p.x = cvtpk(x[8 * s], x[8 * s + 1]); p.y = cvtpk(x[8 * s + 2], x[8 * s + 3]); p.z = cvtpk(x[8 * s + 4], x[8 * s + 5]); p.w = cvtpk(x[8 * s + 6], x[8 * s + 7]);
    return __builtin_bit_cast(bf16x8, p);
}
__device__ __forceinline__ int otid() { int t = threadIdx.x; asm volatile("" : "+v"(t)); return t; }
#define MFMA32(a, b, c) __builtin_amdgcn_mfma_f32_32x32x16_bf16((a), (b), (c), 0, 0, 0)

__device__ __forceinline__ float rstd_from_ssq(const float* ssq, int row) {
    const f32x4* p = (const f32x4*)(ssq + (size_t)row * 16);
    f32x4 a = p[0], b = p[1], c = p[2], d = p[3];
    float s = ((a.x + a.y) + (a.z + a.w)) + ((b.x + b.y) + (b.z + b.w)) + ((c.x + c.y) + (c.z + c.w)) + ((d.x + d.y) + (d.z + d.w));
    return rsqrtf(s * (1.0f / 1024.0f) + EPS);
}
struct EpiScaled {
    static constexpr bool PERM = true, AFTER_DRAIN = false;
    bf16_t* O; int plane_cols; size_t plane_stride; int ldc; const float* ssq; float qscale; unsigned qmask;
    __device__ __forceinline__ void operator()(const f32x4 (&acc)[2][2][4][2], const pg8::Unit& u, int wr, int wc, int fr, int fq) const {
        const int row0 = u.pm * 256 + wr * 64 + fr;
#pragma unroll
        for (int ai = 0; ai < 2; ++ai)
#pragma unroll
            for (int m = 0; m < 4; ++m) {
                const int row = row0 + ai * 128 + m * 16;
                const float rs = rstd_from_ssq(ssq, row);
#pragma unroll
                for (int bj = 0; bj < 2; ++bj) {
                    const int c = u.pn * 256 + 128 * bj + 32 * wc + 8 * fq;
                    const int pl = c / plane_cols, cc = c - pl * plane_cols;
                    const float sc = ((qmask >> pl) & 1u) ? rs * qscale : rs;
                    const f32x4 v0 = acc[ai][bj][m][0] * sc, v1 = acc[ai][bj][m][1] * sc;
                    u32x4 w; w.x = cvtpk(v0[0], v0[1]); w.y = cvtpk(v0[2], v0[3]); w.z = cvtpk(v1[0], v1[1]); w.w = cvtpk(v1[2], v1[3]);
                    *(u32x4*)(O + (size_t)pl * plane_stride + (size_t)row * ldc + cc) = w;
                }
            }
    }
};
struct EpiScaledT {
    static constexpr bool PERM = true, AFTER_DRAIN = false;
    bf16_t* O; int plane_cols; size_t plane_stride; int ldc; const LAS float* rstab; float qscale; unsigned qmask; mutable int ord = 0;
    __device__ __forceinline__ void operator()(const f32x4 (&acc)[2][2][4][2], const pg8::Unit& u, int wr, int wc, int fr, int fq) const {
        const int row0 = u.pm * 256 + wr * 64 + fr;
        const int o = ord++;
#pragma unroll
        for (int ai = 0; ai < 2; ++ai)
#pragma unroll
            for (int m = 0; m < 4; ++m) {
                const int row = row0 + ai * 128 + m * 16;
                const float rs = rstab[o * 256 + (row & 255)];
#pragma unroll
                for (int bj = 0; bj < 2; ++bj) {
                    const int c = u.pn * 256 + 128 * bj + 32 * wc + 8 * fq;
                    const int pl = c / plane_cols, cc = c - pl * plane_cols;
                    const float sc = ((qmask >> pl) & 1u) ? rs * qscale : rs;
                    const f32x4 v0 = acc[ai][bj][m][0] * sc, v1 = acc[ai][bj][m][1] * sc;
                    u32x4 w; w.x = cvtpk(v0[0], v0[1]); w.y = cvtpk(v0[2], v0[3]); w.z = cvtpk(v1[0], v1[1]); w.w = cvtpk(v1[2], v1[3]);
                    *(u32x4*)(O + (size_t)pl * plane_stride + (size_t)row * ldc + cc) = w;
                }
            }
    }
};
struct EpiRes {
    static constexpr bool PERM = true, AFTER_DRAIN = false;
    const float* basef; bf16_t* xb; float* ssq;
    __device__ __forceinline__ void operator()(const f32x4 (&acc)[2][2][4][2], const pg8::Unit& u, int wr, int wc, int fr, int fq) const {
        const int row0 = u.pm * 256 + wr * 64 + fr;
#pragma unroll
        for (int ai = 0; ai < 2; ++ai)
#pragma unroll
            for (int m = 0; m < 4; ++m) {
                const int row = row0 + ai * 128 + m * 16;
                float ss = 0.f;
#pragma unroll
                for (int bj = 0; bj < 2; ++bj) {
                    const int c = u.pn * 256 + 128 * bj + 32 * wc + 8 * fq;
                    const size_t off = (size_t)row * D + c;
                    f32x4 b0, b1;
                    if (basef) { b0 = *(const f32x4*)(basef + off); b1 = *(const f32x4*)(basef + off + 4); }
                    else { const u32x4 r = *(const u32x4*)(xb + off); b0 = (f32x4){bflo(r.x), bfhi(r.x), bflo(r.y), bfhi(r.y)}; b1 = (f32x4){bflo(r.z), bfhi(r.z), bflo(r.w), bfhi(r.w)}; }
                    const f32x4 v0 = b0 + acc[ai][bj][m][0], v1 = b1 + acc[ai][bj][m][1];
                    u32x4 w; w.x = cvtpk(v0[0], v0[1]); w.y = cvtpk(v0[2], v0[3]); w.z = cvtpk(v1[0], v1[1]); w.w = cvtpk(v1[2], v1[3]);
                    *(u32x4*)(xb + off) = w;
                    const float q0 = bflo(w.x), q1 = bfhi(w.x), q2 = bflo(w.y), q3 = bfhi(w.y), q4 = bflo(w.z), q5 = bfhi(w.z), q6 = bflo(w.w), q7 = bfhi(w.w);
                    ss += (q0 * q0 + q1 * q1) + (q2 * q2 + q3 * q3) + (q4 * q4 + q5 * q5) + (q6 * q6 + q7 * q7);
                }
                ss += __shfl_xor(ss, 16); ss += __shfl_xor(ss, 32);
                if (fq == 0) ssq[(size_t)row * 16 + u.pn * 4 + wc] = ss;
            }
    }
};

__device__ __forceinline__ float shr1(float v) { return __builtin_bit_cast(float, __builtin_amdgcn_update_dpp(0, __builtin_bit_cast(int, v), 0x111, 0xf, 0xf, true)); }
struct EpiUp {
    static constexpr bool PERM = true, AFTER_DRAIN = false, APERM = true;
    bf16_t* act; float* head; float* tail; const float* ssq; const float* cwp; const LAS float* rstab; LAS float* cwps; mutable int ord = 0;
    __device__ __forceinline__ void operator()(const f32x4 (&acc)[2][2][4][2], const pg8::Unit& u, int wr, int wc, int fr, int fq) const {
        const int j0 = u.pn * 128 + 32 * wc + 8 * fq;
        const int o = ord++;
        LAS float* cs = cwps + (wr * 4 + wc) * 256;
        *(LAS f32x4*)(cs + (fq * 16 + fr) * 4) = *(const f32x4*)(cwp + (size_t)(u.pn * 128 + 32 * wc) * 8 + (fq * 16 + fr) * 4);
#pragma unroll
        for (int ai = 0; ai < 2; ++ai) {
            const int grp = u.pm * 4 + ai * 2 + wr;
            float rs[4];
#pragma unroll
            for (int m = 0; m < 4; ++m) rs[m] = rstab[o * 256 + ((grp & 3) * 64 + 4 * fr + m)];
#pragma unroll
            for (int n = 0; n < 2; ++n) {
                unsigned res[4][2];
#pragma unroll
                for (int ep = 0; ep < 2; ++ep) {
                    const LAS f32x4* cq = (const LAS f32x4*)(cs + (4 * fq + 2 * n + ep) * 16);
                    const f32x4 A0 = cq[0], A1 = cq[1], A2 = cq[2], A3 = cq[3];
                    const f32x2 W0g = {A0[0], A0[1]}, W1g = {A0[2], A0[3]}, W2g = {A1[0], A1[1]}, Bg = {A1[2], A1[3]};
                    const f32x2 W0u = {A2[0], A2[1]}, W1u = {A2[2], A2[3]}, W2u = {A3[0], A3[1]}, Bu = {A3[2], A3[3]};
                    f32x2 Gv[4], Uv[4];
#pragma unroll
                    for (int m = 0; m < 4; ++m) { Gv[m] = (f32x2){acc[ai][0][m][n][2 * ep], acc[ai][0][m][n][2 * ep + 1]} * rs[m]; Uv[m] = (f32x2){acc[ai][1][m][n][2 * ep], acc[ai][1][m][n][2 * ep + 1]} * rs[m]; }
                    const f32x2 g3s = {shr1(Gv[3].x), shr1(Gv[3].y)}, g2s = {shr1(Gv[2].x), shr1(Gv[2].y)}, u3s = {shr1(Uv[3].x), shr1(Uv[3].y)}, u2s = {shr1(Uv[2].x), shr1(Uv[2].y)};
                    f32x2 hg[4], hu[4];
                    hg[0] = W0g * g2s + W1g * g3s + W2g * Gv[0] + Bg;     hu[0] = W0u * u2s + W1u * u3s + W2u * Uv[0] + Bu;
                    hg[1] = W0g * g3s + W1g * Gv[0] + W2g * Gv[1] + Bg;   hu[1] = W0u * u3s + W1u * Uv[0] + W2u * Uv[1] + Bu;
                    hg[2] = W0g * Gv[0] + W1g * Gv[1] + W2g * Gv[2] + Bg; hu[2] = W0u * Uv[0] + W1u * Uv[1] + W2u * Uv[2] + Bu;
                    hg[3] = W0g * Gv[1] + W1g * Gv[2] + W2g * Gv[3] + Bg; hu[3] = W0u * Uv[1] + W1u * Uv[2] + W2u * Uv[3] + Bu;
                    const int j = j0 + 4 * n + 2 * ep;
                    if (fr == 0) { float* hp = head + (size_t)(grp * 2) * NUP + j; *(f32x2*)hp = Gv[0]; *(f32x2*)(hp + DFF) = Uv[0]; *(f32x2*)(hp + NUP) = Gv[1]; *(f32x2*)(hp + NUP + DFF) = Uv[1]; }
                    if (fr == 15) { float* tp = tail + (size_t)(grp * 2) * NUP + j; *(f32x2*)tp = Gv[2]; *(f32x2*)(tp + DFF) = Uv[2]; *(f32x2*)(tp + NUP) = Gv[3]; *(f32x2*)(tp + NUP + DFF) = Uv[3]; }
#pragma unroll
                    for (int m = 0; m < 4; ++m) {
                        const f32x2 x = hg[m], t = x * (x * x * 0.044715f + 1.0f) * (-2.302208198f);
                        const f32x2 den = (f32x2){ex2(t.x), ex2(t.y)} + 1.0f;
                        const f32x2 val = x * hu[m] * (f32x2){__builtin_amdgcn_rcpf(den.x), __builtin_amdgcn_rcpf(den.y)};
                        res[m][ep] = cvtpk(val.x, val.y);
                    }
                }
#pragma unroll
                for (int m = 0; m < 4; ++m) {
                    if (m >= 2 || fr > 0) { u32x2 w; w.x = res[m][0]; w.y = res[m][1];
                        *(u32x2*)(act + (size_t)(grp * 64 + 4 * fr + m) * DFF + j0 + 4 * n) = w; }
                }
                asm volatile("" ::: "memory");
            }
        }
    }
};

template <class Sched>
__device__ __forceinline__ void rstab_fill(ldsp lds, const Sched S, const float* ssq) {
    LAS float* tab = (LAS float*)(lds + LDS_RSTAB);
    const int t = otid();
#pragma unroll
    for (int i = 0; i < 6; ++i) { pg8::Unit fu; if (S.next(i, fu) && t < 256) tab[i * 256 + t] = rstd_from_ssq(ssq, fu.pm * 256 + t); }
    __syncthreads();
}
#define XB_TMO      128
#define XB_XCNT(j)  (256  + 64 * (j))
#define XB_XSUB(j)  (1280 + 64 * (j))
#define XB_XGEN(j)  (2304 + 64 * (j))
#define XB_TOP      3328
#define XB_TOPGEN   3392
#define XCD_BAR_WORDS 3456
#define XB_SPIN_CAP (1u << 18)
__device__ __forceinline__ unsigned xb_ld(unsigned* p)              { return __hip_atomic_load(p, __ATOMIC_RELAXED, __HIP_MEMORY_SCOPE_AGENT); }
__device__ __forceinline__ unsigned xb_add(unsigned* p, unsigned v) { return __hip_atomic_fetch_add(p, v, __ATOMIC_RELAXED, __HIP_MEMORY_SCOPE_AGENT); }
__device__ __forceinline__ unsigned xb_xcc_id() { return (unsigned)__builtin_amdgcn_s_getreg((3 << 11) | 20) & 0xFu; }
#define XB_SPIN(cond, bar) do { unsigned _sp = 0; while (cond) { __builtin_amdgcn_s_sleep(1); \
    if ((++_sp & 255u) == 0u) { if (xb_ld(&(bar)[XB_TMO])) break; if (_sp > XB_SPIN_CAP) { atomicAdd(&(bar)[XB_TMO], 1u); break; } } } } while (0)

struct XcdBarrier {
    unsigned* bar; unsigned x;
    volatile LAS unsigned* st;
};

__device__ __forceinline__ XcdBarrier xcd_barrier_post(unsigned* bar, volatile LAS unsigned* st) {
    XcdBarrier b; b.bar = bar; b.x = xb_xcc_id(); b.st = st;
    if (threadIdx.x == 0) (void)xb_add(&bar[XB_XCNT(b.x)], 1u);
    return b;
}
__device__ __forceinline__ void xcd_barrier_complete(unsigned* bar, unsigned x, unsigned& nloc, unsigned& nx) {
    const unsigned G = gridDim.x * gridDim.y * gridDim.z;
    unsigned sum, cnt, mine, sp = 0u;
    for (;;) {
        sum = 0u; cnt = 0u; mine = 0u;
#pragma unroll
        for (unsigned j = 0; j < 16; ++j) { const unsigned c = xb_ld(&bar[XB_XCNT(j)]); sum += c; cnt += (c > 0u) ? 1u : 0u; mine = (j == x) ? c : mine; }
        if (sum == G) break;
        __builtin_amdgcn_s_sleep(1);
        if ((++sp & 255u) == 0u) { if (xb_ld(&bar[XB_TMO])) break; if (sp > XB_SPIN_CAP) { atomicAdd(&bar[XB_TMO], 1u); break; } }
    }
    nloc = mine > 0u ? mine : 1u; nx = cnt > 0u ? cnt : 1u;
}

__device__ __forceinline__ void xcd_barrier(const XcdBarrier& b) {
    asm volatile("s_waitcnt vmcnt(0)" ::: "memory");
    __syncthreads();
    if (threadIdx.x == 0) {
        unsigned* bar = b.bar;
        __builtin_amdgcn_s_waitcnt(0);
        unsigned nloc = b.st[0], nx = b.st[1];
        if (nloc == 0u) { xcd_barrier_complete(bar, b.x, nloc, nx); b.st[0] = nloc; b.st[1] = nx; }
        const unsigned old = xb_add(&bar[XB_XSUB(b.x)], 1u);
        const unsigned gen = old / nloc;
        if (old + 1u == (gen + 1u) * nloc) {
            __builtin_amdgcn_fence(__ATOMIC_RELEASE, "agent");
            asm volatile("s_waitcnt vmcnt(0)" ::: "memory");
            const unsigned og = xb_add(&bar[XB_TOP], 1u);
            const unsigned tg = og / nx;
            if (og + 1u == (tg + 1u) * nx) xb_add(&bar[XB_TOPGEN], 1u);
            else XB_SPIN(xb_ld(&bar[XB_TOPGEN]) == tg, bar);
            __builtin_amdgcn_fence(__ATOMIC_ACQUIRE, "agent");
            xb_add(&bar[XB_XGEN(b.x)], 1u);
            asm volatile("s_waitcnt vmcnt(0)" ::: "memory");
        } else {
            XB_SPIN(xb_ld(&bar[XB_XGEN(b.x)]) == gen, bar);
            __builtin_amdgcn_fence(__ATOMIC_ACQUIRE, "agent");
            asm volatile("s_waitcnt vmcnt(0)" ::: "memory");
        }
    }
    __syncthreads();
}


struct Args { const float* in[28]; float* out; unsigned char* ws; };

__device__ __forceinline__ void wt_item(const float* W, int K, int Nsrc, int srccol0, bf16_t* WT, int dstrow0, const float* gain, int k0, ldsp scr, int lane) {
    const int c4 = lane & 15, rr = lane >> 4;
    f32x4 w[16];
#pragma unroll
    for (int i = 0; i < 16; ++i) w[i] = *(const f32x4*)(W + (size_t)(k0 + 4 * i + rr) * Nsrc + srccol0 + 4 * c4);
#pragma unroll
    for (int i = 0; i < 16; ++i) { const float g = gain ? gain[k0 + 4 * i + rr] : 1.f; const unsigned a = cvtpk(w[i].x * g, w[i].y * g), b = cvtpk(w[i].z * g, w[i].w * g);
        ldsp p = scr + (4 * c4) * 132 + (4 * i + rr) * 2;
        *(LAS bf16_t*)(p) = (bf16_t)(a & 0xffffu); *(LAS bf16_t*)(p + 132) = (bf16_t)(a >> 16); *(LAS bf16_t*)(p + 264) = (bf16_t)(b & 0xffffu); *(LAS bf16_t*)(p + 396) = (bf16_t)(b >> 16); }
    asm volatile("s_waitcnt lgkmcnt(0)" ::: "memory");
    const int c = lane & 7;
#pragma unroll
    for (int j = 0; j < 8; ++j) { const int n = 8 * j + (lane >> 3); const LAS unsigned* s = (const LAS unsigned*)(scr + n * 132 + c * 16);
        u32x4 o; o.x = s[0]; o.y = s[1]; o.z = s[2]; o.w = s[3];
        *(u32x4*)(WT + (size_t)(dstrow0 + n) * K + k0 + 8 * c) = o; }
    asm volatile("s_waitcnt lgkmcnt(0)" ::: "memory");
}
__device__ __forceinline__ void wt_dispatch(const Args& A, int it, ldsp scr, int lane) {
    const float* W; bf16_t* WT; const float* gain = nullptr; int K = 1024, Nsrc, Ndst, mode = 0, r = it;
    unsigned char* ws = A.ws;
    if (r < 768) { W = A.in[6]; WT = (bf16_t*)(ws + WS_WIN0); gain = A.in[2]; Nsrc = 3080; Ndst = 3072; mode = 1; }
    else if ((r -= 768) < 256) { W = A.in[13]; WT = (bf16_t*)(ws + WS_WOUT0); Nsrc = 1024; Ndst = 1024; }
    else if ((r -= 256) < 512) { const int l = r / 256; r -= l * 256; W = A.in[20] + (size_t)l * 1024 * 1024; WT = (bf16_t*)(ws + WS_WQ) + (size_t)l * 1024 * 1024; gain = A.in[3] + l * 1024; Nsrc = 1024; Ndst = 1024; }
    else if ((r -= 512) < 1024) { const int l = r / 512; r -= l * 512; W = A.in[21] + (size_t)l * 1024 * 2048; WT = (bf16_t*)(ws + WS_WKV) + (size_t)l * 2048 * 1024; gain = A.in[4] + l * 1024; Nsrc = 2048; Ndst = 2048; }
    else if ((r -= 1024) < 512) { const int l = r / 256; r -= l * 256; W = A.in[22] + (size_t)l * 1024 * 1024; WT = (bf16_t*)(ws + WS_WO) + (size_t)l * 1024 * 1024; Nsrc = 1024; Ndst = 1024; }
    else if ((r -= 512) < 2816) { const int l = r / 1408; r -= l * 1408; W = A.in[23] + (size_t)l * 1024 * NUP; WT = (bf16_t*)(ws + WS_WUP) + (size_t)l * NUP * 1024; gain = A.in[5] + l * 1024; Nsrc = NUP; Ndst = NUP; mode = 3; }
    else if ((r -= 2816) < 1408) { const int l = r / 704; r -= l * 704; W = A.in[26] + (size_t)l * DFF * 1024; WT = (bf16_t*)(ws + WS_WDN) + (size_t)l * 1024 * DFF; K = DFF; Nsrc = 1024; Ndst = 1024; }
    else if ((r -= 1408) < 768) { W = A.in[14]; WT = (bf16_t*)(ws + WS_WIN1); gain = A.in[2] + 1024; Nsrc = 3080; Ndst = 3072; mode = 2; }
    else { r -= 768; W = A.in[19]; WT = (bf16_t*)(ws + WS_WOUT1); Nsrc = 1024; Ndst = 1024; }
    const int nblk = Ndst / 64, kb = r / nblk, nb = r % nblk, n0 = nb * 64;
    int sc = n0;
    if (mode == 1) sc = n0 < 1536 ? n0 : n0 + 8;
    else if (mode == 2) sc = n0 < 2048 ? n0 : n0 + 8;
    else if (mode == 3) { const int p = n0 >> 8, i = n0 & 255; sc = i < 128 ? 128 * p + i : DFF + 128 * p + (i - 128); }
    wt_item(W, K, Nsrc, sc, WT, n0, gain, kb * 64, scr, lane);
}
constexpr int WT_ITEMS = 8320;

template <int MODE>
__device__ __forceinline__ void row_pass(const Args& A, ldsp lds, const float* X, const float* Wg, int col0, const float* gain, int gw, int ngw, int tid, int lane) {
    LAS float* gwl = (LAS float*)lds;
    for (int i = tid; i < 1024 * 2; i += 512) { const int k = i >> 1, hf = i & 1; const f32x4 w = *(const f32x4*)(Wg + (size_t)k * 3080 + col0 + 4 * hf); const float g = gain[k];
        gwl[(4 * hf + 0) * 1024 + k] = w.x * g; gwl[(4 * hf + 1) * 1024 + k] = w.y * g; gwl[(4 * hf + 2) * 1024 + k] = w.z * g; gwl[(4 * hf + 3) * 1024 + k] = w.w * g; }
    __syncthreads();
    unsigned char* ws = A.ws;
    bf16_t* xb = (bf16_t*)(ws + WS_XB); float* ssq = (float*)(ws + WS_SSQ); float* gate = (float*)(ws + WS_GATE);
    f32x4 nx[4];
    if (gw < T) {
#pragma unroll
        for (int j = 0; j < 4; ++j) nx[j] = ((const f32x4*)(X + (size_t)gw * D) + lane)[64 * j];
    }
    for (int m = gw; m < T; m += ngw) {
        f32x4 v[4]; float s = 0.f;
#pragma unroll
        for (int j = 0; j < 4; ++j) { v[j] = nx[j]; s += (v[j].x * v[j].x + v[j].y * v[j].y) + (v[j].z * v[j].z + v[j].w * v[j].w); }
        if (m + ngw < T) {
#pragma unroll
            for (int j = 0; j < 4; ++j) nx[j] = ((const f32x4*)(X + (size_t)(m + ngw) * D) + lane)[64 * j];
        }
        s = wave_sum(s);
        const float rstd = rsqrtf(s * (1.0f / 1024.0f) + EPS);
        if (MODE == 0) {
            u32x2* o8 = (u32x2*)(xb + (size_t)m * D) + lane;
#pragma unroll
            for (int j = 0; j < 4; ++j) { u32x2 w; w.x = cvtpk(v[j].x, v[j].y); w.y = cvtpk(v[j].z, v[j].w); o8[64 * j] = w; }
            if (lane < 16) ssq[(size_t)m * 16 + lane] = lane == 0 ? s : 0.f;
        }
        float z[8];
#pragma unroll
        for (int c = 0; c < 8; ++c) { float d = 0.f;
#pragma unroll
            for (int j = 0; j < 4; ++j) { const f32x4 w = *(const LAS f32x4*)(gwl + c * 1024 + 256 * j + 4 * lane); d += (v[j].x * w.x + v[j].y * w.y) + (v[j].z * w.z + v[j].w * w.w); }
            z[c] = wave_sum(d) * rstd; }
        float zc = z[0];
#pragma unroll
        for (int c = 1; c < 8; ++c) zc = lane == c ? z[c] : zc;
        const int b = m >> 12, t = m & 4095;
        if (MODE == 0) { if (lane < 8) gate[(size_t)(b * 8 + lane) * SEQ + t] = log_sigmoid(zc + A.in[7][lane]); }
        else { if (lane < 4) gate[(size_t)(b * 4 + lane) * SEQ + t] = zc + A.in[16][lane];
               else if (lane < 8) gate[(size_t)(16 + b * 4 + lane - 4) * SEQ + t] = log_sigmoid(zc + A.in[17][lane - 4]); }
    }
    __syncthreads();
}

__device__ __forceinline__ void seq_cumsum(float* p, float scale, LAS float* scr, int tid, int lane, int wid) {
    f32x4 a = ((const f32x4*)p)[2 * tid], b = ((const f32x4*)p)[2 * tid + 1];
    a.y += a.x; a.z += a.y; a.w += a.z; b.x += a.w; b.y += b.x; b.z += b.y; b.w += b.z;
    float tot = b.w, inc = tot;
#pragma unroll
    for (int o = 1; o < 64; o <<= 1) { const float n = __shfl_up(inc, o); if (lane >= o) inc += n; }
    if (lane == 63) scr[wid] = inc;
    __syncthreads();
    float pre = inc - tot;
    for (int w = 0; w < wid; ++w) pre += scr[w];
    a = (a + pre) * scale; b = (b + pre) * scale;
    ((f32x4*)p)[2 * tid] = a; ((f32x4*)p)[2 * tid + 1] = b;
    __syncthreads();
}

__device__ __forceinline__ float xhalf_max(float m) { const auto rr = __builtin_amdgcn_permlane32_swap(__float_as_uint(m), __float_as_uint(m), false, false); return fmaxf(__uint_as_float(rr[0]), __uint_as_float(rr[1])); }
__device__ __forceinline__ float max3f(float a, float b, float c) { float r; asm("v_max3_f32 %0, %1, %2, %3" : "=v"(r) : "v"(a), "v"(b), "v"(c)); return r; }
template <int DQK, int DV, int MODE> struct FC {
    static constexpr int KT = (MODE == 1) ? 128 : 64;
    static constexpr int PK = DQK * 2 + 16, PV = DV * 2 + 64, KB = KT * PK, VB = KT * PV, STAGE = KB + VB + KT * 4;
    static constexpr int NCK = KT * DQK / 8 / 512, NCV = KT * DV / 8 / 512;
};
template <int DQK, int DV, int MODE, int NCK, int NCV>
__device__ __forceinline__ void fl_gload(u32x4 (&kr)[NCK], u32x4 (&vr)[NCV], float& fr_, const bf16_t* K, int kp, const bf16_t* V, int vp, const float* Fl, int kv0, int tid, int part = 3) {
    if (part & 1)
#pragma unroll
    for (int i = 0; i < NCK; ++i) { const int cid = tid + 512 * i, row = cid / (DQK / 8), cc = cid % (DQK / 8); kr[i] = *(const u32x4*)(K + (size_t)(kv0 + row) * kp + cc * 8); }
    if (part & 2)
#pragma unroll
    for (int i = 0; i < NCV; ++i) { const int cid = tid + 512 * i, row = cid / (DV / 8), cc = cid % (DV / 8); vr[i] = *(const u32x4*)(V + (size_t)(kv0 + row) * vp + cc * 8); }
    if (MODE == 1 && (part & 1)) { if (tid < FC<DQK, DV, MODE>::KT) fr_ = Fl[kv0 + tid]; }
}
template <int DQK, int DV, int MODE, int NCK, int NCV>
__device__ __forceinline__ void fl_sstore(ldsp st, const u32x4 (&kr)[NCK], const u32x4 (&vr)[NCV], float fr_, int tid) {
    typedef FC<DQK, DV, MODE> C;
#pragma unroll
    for (int i = 0; i < C::NCK; ++i) { const int cid = tid + 512 * i, row = cid / (DQK / 8), cc = cid % (DQK / 8); *(LAS u32x4*)(st + row * C::PK + cc * 16) = kr[i]; }
#pragma unroll
    for (int i = 0; i < C::NCV; ++i) { const int cid = tid + 512 * i, row = cid / (DV / 8), cc = cid % (DV / 8); *(LAS u32x4*)(st + C::KB + row * C::PV + cc * 16) = vr[i]; }
    if (MODE == 1) { if (tid < C::KT) *(LAS float*)(st + C::KB + C::VB + tid * 4) = -fr_; }
}
template <int DQK, int DV, int MODE>
__device__ __forceinline__ void flash_unit(ldsp lds, LAS float* wscr, const bf16_t* Q, int qp, const bf16_t* K, int kp, const bf16_t* V, int vp, const float* Fl,
                                           int q0, int ntiles, f32x16 (&o)[DV / 32]) {
    typedef FC<DQK, DV, MODE> C;
    const int tid = otid(), lane = tid & 63, wid = __builtin_amdgcn_readfirstlane(tid >> 6), n = lane & 31, h = lane >> 5;
    const int i16 = lane & 15, q4 = i16 >> 2, p4 = i16 & 3, blk = (lane >> 4) & 1;
    const int qw = q0 + 32 * wid;
    bf16x8 qf[DQK / 16];
#pragma unroll
    for (int st = 0; st < DQK / 16; ++st) qf[st] = *(const bf16x8*)(Q + (size_t)(qw + n) * qp + 16 * st + 8 * h);
#pragma unroll
    for (int db = 0; db < DV / 32; ++db)
#pragma unroll
        for (int r = 0; r < 16; ++r) o[db][r] = 0.f;
    float mrun = -1e30f, lrun = 0.f;
    const int jmax_w = (MODE == 0) ? ntiles - 1 : (qw >> 6);
    u32x4 kr[C::NCK], vr[C::NCV]; float frg = 0.f;
    fl_gload<DQK, DV, MODE, C::NCK, C::NCV>(kr, vr, frg, K, kp, V, vp, Fl, 0, tid);
    fl_sstore<DQK, DV, MODE, C::NCK, C::NCV>(lds, kr, vr, frg, tid);
    __syncthreads();
    constexpr int SUBS = C::KT / 64;
    if (wid >= 4) __builtin_amdgcn_s_setprio(1);
    for (int j0 = 0; j0 < ntiles; j0 += SUBS) {
        ldsp st = lds + ((j0 / SUBS) & 1) * C::STAGE;
        if (j0 + SUBS < ntiles) fl_gload<DQK, DV, MODE, C::NCK, C::NCV>(kr, vr, frg, K, kp, V, vp, Fl, 64 * (j0 + SUBS), tid, 3);
#pragma unroll
        for (int sub = 0; sub < SUBS; ++sub) {
        const int j = j0 + sub;
        if (j <= jmax_w) {
            f32x16 p0, p1;
            if (MODE == 1) {
                const LAS float* fb = (const LAS float*)(st + C::KB + C::VB) + 64 * sub;
#pragma unroll
                for (int g = 0; g < 4; ++g) { const f32x4 f0 = *(const LAS f32x4*)(fb + 8 * g + 4 * h), f1 = *(const LAS f32x4*)(fb + 32 + 8 * g + 4 * h);
#pragma unroll
                    for (int e = 0; e < 4; ++e) { p0[4 * g + e] = f0[e]; p1[4 * g + e] = f1[e]; } }
            }
            ldsp ka = st + (64 * sub + n) * C::PK + 16 * h;
            const f32x16 zero16 = {0.f, 0.f, 0.f, 0.f, 0.f, 0.f, 0.f, 0.f, 0.f, 0.f, 0.f, 0.f, 0.f, 0.f, 0.f, 0.f};
#pragma unroll
            for (int s = 0; s < DQK / 16; ++s) {
                const bf16x8 a0 = *(const LAS bf16x8*)(ka + 32 * s), a1 = *(const LAS bf16x8*)(ka + 32 * C::PK + 32 * s);
                if (MODE != 1 && s == 0) { p0 = MFMA32(a0, qf[s], zero16); p1 = MFMA32(a1, qf[s], zero16); }
                else { p0 = MFMA32(a0, qf[s], p0); p1 = MFMA32(a1, qf[s], p1); }
            }
            if (MODE == 1) {
                if (j == jmax_w) { const int ql = qw - 64 * j + n;
#pragma unroll
                    for (int r = 0; r < 16; ++r) { const int kvl = crow(r, h); if (kvl > ql) p0[r] = -INFINITY; if (kvl + 32 > ql) p1[r] = -INFINITY; } }
            }
            float mx = fmaxf(p0[0], p1[0]);
#pragma unroll
            for (int r = 1; r < 16; ++r) mx = max3f(mx, p0[r], p1[r]);
            mx = fmaxf(mx, __shfl_xor(mx, 32));
            float alpha = 1.0f;
            if (__any(mx - mrun > 8.0f)) {
                const float mnew = fmaxf(mrun, mx); alpha = ex2(mrun - mnew); mrun = mnew;
                wscr[n] = alpha;
                asm volatile("s_waitcnt lgkmcnt(0)" ::: "memory");
#pragma unroll
                for (int g = 0; g < 4; ++g) { const f32x4 a4 = *(const LAS f32x4*)(wscr + 8 * g + 4 * h);
#pragma unroll
                    for (int db = 0; db < DV / 32; ++db)
#pragma unroll
                        for (int e = 0; e < 4; ++e) o[db][4 * g + e] *= a4[e]; }
            }
            f32x2 rs2 = {0.f, 0.f};
#pragma unroll
            for (int r = 0; r < 16; r += 2) {
                const f32x2 a = (f32x2){p0[r], p0[r + 1]} - mrun, b = (f32x2){p1[r], p1[r + 1]} - mrun;
                const f32x2 ea = {ex2(a.x), ex2(a.y)}, eb = {ex2(b.x), ex2(b.y)};
                p0[r] = ea.x; p0[r + 1] = ea.y; p1[r] = eb.x; p1[r + 1] = eb.y;
                rs2 = rs2 + ea + eb;
            }
            lrun = lrun * alpha + (rs2.x + rs2.y);
            ldsp vb = st + C::KB + (64 * sub + 4 * h + q4) * C::PV + blk * 32 + 8 * p4;
#pragma unroll
            for (int ks = 0; ks < 4; ++ks) {
                const bf16x8 pa = (ks & 2) ? pack8(p1, ks & 1) : pack8(p0, ks & 1);
#pragma unroll
                for (int db = 0; db < DV / 32; ++db) {
                    const bf16x8 bv = tr8(vb + (16 * ks) * C::PV + db * 64, 8 * C::PV);
                    o[db] = MFMA32(pa, bv, o[db]);
                }
            }
        }
        }
        if (j0 + SUBS < ntiles) fl_sstore<DQK, DV, MODE, C::NCK, C::NCV>(lds + (((j0 / SUBS) + 1) & 1) * C::STAGE, kr, vr, frg, tid);
        __syncthreads();
    }
    __builtin_amdgcn_s_setprio(0);
    lrun += __shfl_xor(lrun, 32);
    wscr[n] = 1.0f / lrun;
    asm volatile("s_waitcnt lgkmcnt(0)" ::: "memory");
#pragma unroll
    for (int g = 0; g < 4; ++g) { const f32x4 a4 = *(const LAS f32x4*)(wscr + 8 * g + 4 * h);
#pragma unroll
        for (int db = 0; db < DV / 32; ++db)
#pragma unroll
            for (int e = 0; e < 4; ++e) o[db][4 * g + e] *= a4[e]; }
    asm volatile("" ::: "memory");
}

__device__ __forceinline__ void row_gates_b(const Args& A, ldsp lds, const bf16_t* X, const float* Wg, int col0, const float* gain, int gw, int ngw, int tid, int lane) {
    LAS float* gwl = (LAS float*)lds;
    for (int i = tid; i < 1024 * 2; i += 512) { const int k = i >> 1, hf = i & 1; const f32x4 w = *(const f32x4*)(Wg + (size_t)k * 3080 + col0 + 4 * hf); const float g = gain[k];
        gwl[(4 * hf + 0) * 1024 + k] = w.x * g; gwl[(4 * hf + 1) * 1024 + k] = w.y * g; gwl[(4 * hf + 2) * 1024 + k] = w.z * g; gwl[(4 * hf + 3) * 1024 + k] = w.w * g; }
    __syncthreads();
    float* gate = (float*)(A.ws + WS_GATE);
    u32x4 nx[2];
    if (gw < T) { nx[0] = ((const u32x4*)(X + (size_t)gw * D))[lane]; nx[1] = ((const u32x4*)(X + (size_t)gw * D))[64 + lane]; }
    for (int m = gw; m < T; m += ngw) {
        float v[2][8]; float s = 0.f;
#pragma unroll
        for (int j = 0; j < 2; ++j) { const u32x4 r = nx[j];
            v[j][0] = bflo(r.x); v[j][1] = bfhi(r.x); v[j][2] = bflo(r.y); v[j][3] = bfhi(r.y); v[j][4] = bflo(r.z); v[j][5] = bfhi(r.z); v[j][6] = bflo(r.w); v[j][7] = bfhi(r.w);
#pragma unroll
            for (int e = 0; e < 8; ++e) s += v[j][e] * v[j][e]; }
        if (m + ngw < T) { nx[0] = ((const u32x4*)(X + (size_t)(m + ngw) * D))[lane]; nx[1] = ((const u32x4*)(X + (size_t)(m + ngw) * D))[64 + lane]; }
        s = wave_sum(s);
        const float rstd = rsqrtf(s * (1.0f / 1024.0f) + EPS);
        float z[8];
#pragma unroll
        for (int c = 0; c < 8; ++c) { float d = 0.f;
#pragma unroll
            for (int j = 0; j < 2; ++j) { const f32x4 w0 = *(const LAS f32x4*)(gwl + c * 1024 + 512 * j + 8 * lane), w1 = *(const LAS f32x4*)(gwl + c * 1024 + 512 * j + 8 * lane + 4);
                d += (v[j][0] * w0.x + v[j][1] * w0.y) + (v[j][2] * w0.z + v[j][3] * w0.w) + (v[j][4] * w1.x + v[j][5] * w1.y) + (v[j][6] * w1.z + v[j][7] * w1.w); }
            z[c] = wave_sum(d) * rstd; }
        float zc = z[0];
#pragma unroll
        for (int c = 1; c < 8; ++c) zc = lane == c ? z[c] : zc;
        const int b = m >> 12, tt = m & 4095;
        if (lane < 4) gate[(size_t)(b * 4 + lane) * SEQ + tt] = zc + A.in[16][lane];
        else if (lane < 8) gate[(size_t)(16 + b * 4 + lane - 4) * SEQ + tt] = log_sigmoid(zc + A.in[17][lane - 4]);
    }
    __syncthreads();
}

__device__ __forceinline__ void fox_unit(const Args& A, ldsp lds, LAS float* wscr, int bh, int qb) {
    unsigned char* ws = A.ws;
    const int b = bh >> 3, hd = bh & 7, tid_ = otid(), lane = tid_ & 63, wid = tid_ >> 6, n = lane & 31, h = lane >> 5;
    const bf16_t* P = (const bf16_t*)(ws + WS_R1);
    const size_t PS = (size_t)T * 512, ro = (size_t)b * SEQ * 512 + hd * 64;
    f32x16 o[2];
    flash_unit<64, 64, 1>(lds, wscr, P + ro, 512, P + PS + ro, 512, P + 2 * PS + ro, 512, (const float*)(ws + WS_GATE) + (size_t)bh * SEQ, qb * 256, qb * 4 + 4, o);
    bf16_t* mixed = (bf16_t*)(ws + WS_R2);
    const int qw = qb * 256 + 32 * wid;
#pragma unroll
    for (int db = 0; db < 2; ++db)
#pragma unroll
        for (int r = 0; r < 16; ++r) mixed[(size_t)(b * SEQ + qw + crow(r, h)) * D + hd * 64 + db * 32 + n] = f2bf(o[db][r]);
}
__device__ __forceinline__ void diff_unit(const Args& A, ldsp lds, LAS float* wscr, int bh, int qb) {
    unsigned char* ws = A.ws;
    const int b = bh >> 2, hd = bh & 3, tid_ = otid(), lane = tid_ & 63, wid = tid_ >> 6, n = lane & 31, h = lane >> 5;
    const bf16_t* P = (const bf16_t*)(ws + WS_R1);
    const size_t PS = (size_t)T * 512, ro = (size_t)b * SEQ * 512 + hd * 128;
    const float lam = ((const float*)(ws + WS_MISC))[0];
    f32x16 o[4];
    flash_unit<64, 128, 2>(lds, wscr, P + 3 * PS + ro, 512, P + 4 * PS + ro, 512, P + 5 * PS + ro, 512, nullptr, qb * 256, qb * 4 + 4, o);
    LAS unsigned* o1s = (LAS unsigned*)(lds + 60416 + wid * 8192) + lane;
#pragma unroll
    for (int db = 0; db < 4; ++db)
#pragma unroll
        for (int r = 0; r < 8; ++r) o1s[(db * 8 + r) * 64] = cvtpk(o[db][2 * r], o[db][2 * r + 1]);
    flash_unit<64, 128, 2>(lds, wscr, P + 3 * PS + ro + 64, 512, P + 4 * PS + ro + 64, 512, P + 5 * PS + ro, 512, nullptr, qb * 256, qb * 4 + 4, o);
    float ss[16];
#pragma unroll
    for (int r = 0; r < 16; ++r) ss[r] = 0.f;
#pragma unroll
    for (int db = 0; db < 4; ++db)
#pragma unroll
        for (int r = 0; r < 8; ++r) { const unsigned o1v = o1s[(db * 8 + r) * 64]; const float d0 = bflo(o1v) - lam * o[db][2 * r], d1 = bfhi(o1v) - lam * o[db][2 * r + 1]; o[db][2 * r] = d0; o[db][2 * r + 1] = d1; ss[2 * r] += d0 * d0; ss[2 * r + 1] += d1 * d1; }
#pragma unroll
    for (int r = 0; r < 16; ++r) {
#pragma unroll
        for (int x = 1; x < 32; x <<= 1) ss[r] += __shfl_xor(ss[r], x);
        ss[r] = rsqrtf(ss[r] * (1.0f / 128.0f) + EPS) * 0.8f; }
    bf16_t* mixed = (bf16_t*)(ws + WS_R2);
    const int qw = qb * 256 + 32 * wid;
#pragma unroll
    for (int db = 0; db < 4; ++db) { const float g = A.in[12][db * 32 + n];
#pragma unroll
        for (int r = 0; r < 16; ++r) mixed[(size_t)(b * SEQ + qw + crow(r, h)) * D + 512 + hd * 128 + db * 32 + n] = f2bf(o[db][r] * ss[r] * g); }
}
__device__ __forceinline__ void xattn_unit(const Args& A, ldsp lds, LAS float* wscr, int layer, int u) {
    unsigned char* ws = A.ws;
    const int dvh = u & 1, qb = (u >> 1) & 15, hd = (u >> 5) & 3, b = u >> 7, tid_ = otid(), lane = tid_ & 63, wid = tid_ >> 6, n = lane & 31, h = lane >> 5;
    const bf16_t* QX = (const bf16_t*)(ws + WS_R1) + (size_t)b * SEQ * D + hd * 256;
    const bf16_t* KV = (const bf16_t*)(ws + WS_KV) + (size_t)layer * MEMT * 2048 + (size_t)b * 256 * 2048 + hd * 256;
    f32x16 o[4];
    flash_unit<256, 128, 0>(lds, wscr, QX, D, KV, 2048, KV + 1024 + dvh * 128, 2048, nullptr, qb * 256, 4, o);
    bf16_t* xo = (bf16_t*)(ws + WS_R1 + 32 * MiB);
    const int qw = qb * 256 + 32 * wid;
#pragma unroll
    for (int db = 0; db < 4; ++db)
#pragma unroll
        for (int r = 0; r < 16; ++r) xo[(size_t)(b * SEQ + qw + crow(r, h)) * D + hd * 256 + dvh * 128 + db * 32 + n] = f2bf(o[db][r]);
}
__device__ __forceinline__ void xattn_unit2(const Args& A, ldsp lds, LAS float* wscr, int layer, int b, int hd, int qb) {
    constexpr int PK = 528, KBY = 64 * PK, PV = 320, VBY = 64 * PV;
    unsigned char* ws = A.ws;
    const int tid = otid(), lane = tid & 63, wid = tid >> 6, n = lane & 31, h = lane >> 5, i16 = lane & 15, q4 = i16 >> 2, p4 = i16 & 3, blk = (lane >> 4) & 1;
    const int qw = qb * 256 + 32 * wid;
    const bf16_t* Q = (const bf16_t*)(ws + WS_R1) + (size_t)b * SEQ * D + hd * 256;
    const bf16_t* Kp = (const bf16_t*)(ws + WS_KV) + (size_t)layer * MEMT * 2048 + (size_t)b * 256 * 2048 + hd * 256;
    const bf16_t* Vp = Kp + 1024;
    bf16x8 qf[16];
#pragma unroll
    for (int st = 0; st < 16; ++st) qf[st] = *(const bf16x8*)(Q + (size_t)(qw + n) * D + 16 * st + 8 * h);
    u32x4 kr[4];
#pragma unroll
    for (int i = 0; i < 4; ++i) { const int cid = tid + 512 * i, row = cid >> 5, cc = cid & 31; kr[i] = *(const u32x4*)(Kp + (size_t)row * 2048 + cc * 8); }
#pragma unroll
    for (int i = 0; i < 4; ++i) { const int cid = tid + 512 * i, row = cid >> 5, cc = cid & 31; *(LAS u32x4*)(lds + row * PK + cc * 16) = kr[i]; }
    __syncthreads();
    f32x16 S[8];
#pragma unroll
    for (int j = 0; j < 4; ++j) {
        ldsp st = lds + (j & 1) * KBY;
        if (j < 3) {
#pragma unroll
            for (int i = 0; i < 4; ++i) { const int cid = tid + 512 * i, row = cid >> 5, cc = cid & 31; kr[i] = *(const u32x4*)(Kp + (size_t)(64 * (j + 1) + row) * 2048 + cc * 8); }
        }
        ldsp ka = st + n * PK + 16 * h;
        const f32x16 zero16 = {0.f, 0.f, 0.f, 0.f, 0.f, 0.f, 0.f, 0.f, 0.f, 0.f, 0.f, 0.f, 0.f, 0.f, 0.f, 0.f};
#pragma unroll
        for (int s = 0; s < 16; ++s) {
            const bf16x8 a0 = *(const LAS bf16x8*)(ka + 32 * s), a1 = *(const LAS bf16x8*)(ka + 32 * PK + 32 * s);
            if (s == 0) { S[2 * j] = MFMA32(a0, qf[s], zero16); S[2 * j + 1] = MFMA32(a1, qf[s], zero16); }
            else { S[2 * j] = MFMA32(a0, qf[s], S[2 * j]); S[2 * j + 1] = MFMA32(a1, qf[s], S[2 * j + 1]); }
        }
        if (j < 3) {
#pragma unroll
            for (int i = 0; i < 4; ++i) { const int cid = tid + 512 * i, row = cid >> 5, cc = cid & 31; *(LAS u32x4*)(lds + ((j + 1) & 1) * KBY + row * PK + cc * 16) = kr[i]; }
        }
        __syncthreads();
    }
    u32x4 vr[2];
#pragma unroll
    for (int i = 0; i < 2; ++i) { const int cid = tid + 512 * i, row = cid >> 4, cc = cid & 15; vr[i] = *(const u32x4*)(Vp + (size_t)row * 2048 + cc * 8); }
    float mx = S[0][0];
#pragma unroll
    for (int t = 0; t < 8; ++t)
#pragma unroll
        for (int r = 0; r < 16; r += 2) mx = max3f(mx, S[t][r], S[t][r + 1]);
    mx = xhalf_max(mx);
    f32x2 rs2 = {0.f, 0.f};
    bf16x8 P[8][2];
#pragma unroll
    for (int t = 0; t < 8; ++t) {
#pragma unroll
        for (int r = 0; r < 16; r += 2) { const f32x2 a = (f32x2){S[t][r], S[t][r + 1]} - mx; const f32x2 e = {ex2(a.x), ex2(a.y)}; S[t][r] = e.x; S[t][r + 1] = e.y; rs2 = rs2 + e; }
        P[t][0] = pack8(S[t], 0); P[t][1] = pack8(S[t], 1);
    }
    float lsum = rs2.x + rs2.y; lsum += __shfl_xor(lsum, 32);
    wscr[n] = 1.0f / lsum;
    asm volatile("s_waitcnt lgkmcnt(0)" ::: "memory");
    f32x4 linv[4];
#pragma unroll
    for (int g = 0; g < 4; ++g) linv[g] = *(const LAS f32x4*)(wscr + 8 * g + 4 * h);
#pragma unroll
    for (int i = 0; i < 2; ++i) { const int cid = tid + 512 * i, row = cid >> 4, cc = cid & 15; *(LAS u32x4*)(lds + row * PV + cc * 16) = vr[i]; }
    __syncthreads();
    bf16_t* xo = (bf16_t*)(ws + WS_R1 + 32 * MiB);
    f32x16 o[4];
#pragma unroll
    for (int t = 0; t < 8; ++t) {
        const int j = t & 3, dvh = t >> 2;
        ldsp st = lds + (t & 1) * VBY;
        if (t < 7) {
#pragma unroll
            for (int i = 0; i < 2; ++i) { const int cid = tid + 512 * i, row = cid >> 4, cc = cid & 15; vr[i] = *(const u32x4*)(Vp + (size_t)(64 * ((t + 1) & 3) + row) * 2048 + ((t + 1) >> 2) * 128 + cc * 8); }
        }
        if (j == 0) {
#pragma unroll
            for (int db = 0; db < 4; ++db)
#pragma unroll
                for (int r = 0; r < 16; ++r) o[db][r] = 0.f;
        }
        ldsp vb = st + (4 * h + q4) * PV + blk * 32 + 8 * p4;
#pragma unroll
        for (int ks = 0; ks < 4; ++ks) {
            const bf16x8 pa = P[2 * j + (ks >> 1)][ks & 1];
#pragma unroll
            for (int db = 0; db < 4; ++db) { const bf16x8 bv = tr8(vb + (16 * ks) * PV + db * 64, 8 * PV); o[db] = MFMA32(pa, bv, o[db]); }
        }
        if (j == 3) {
#pragma unroll
            for (int db = 0; db < 4; ++db)
#pragma unroll
                for (int r = 0; r < 16; ++r) xo[(size_t)(b * SEQ + qw + crow(r, h)) * D + hd * 256 + dvh * 128 + db * 32 + n] = f2bf(o[db][r] * linv[r >> 2][r & 3]);
        }
        if (t < 7) {
#pragma unroll
            for (int i = 0; i < 2; ++i) { const int cid = tid + 512 * i, row = cid >> 4, cc = cid & 15; *(LAS u32x4*)(lds + ((t + 1) & 1) * VBY + row * PV + cc * 16) = vr[i]; }
        }
        __syncthreads();
    }
}
__device__ __forceinline__ int next_unit(unsigned* ctr, LAS int* bc) {
    __syncthreads();
    if (threadIdx.x == 0) bc[0] = (int)atomicAdd(ctr, 1u);
    __syncthreads();
    return bc[0];
}

__device__ __forceinline__ void ffn_fixup(const Args& A, int layer, int gt, int ngt) {
    unsigned char* ws = A.ws;
    const float* head = (const float*)(ws + WS_R2); const float* tail = head + (size_t)512 * NUP;
    bf16_t* act = (bf16_t*)(ws + WS_R1);
    const float* cw = A.in[24] + (size_t)layer * 3 * NUP; const float* cb = A.in[25] + (size_t)layer * NUP;
    for (int it = gt; it < 256 * 2 * (DFF / 4); it += ngt) {
        const int j = (it % (DFF / 4)) * 4, rr = (it / (DFF / 4)) & 1, G = it / (DFF / 2);
        const bool first = (G & 63) == 0;
        f32x4 hv[2];
#pragma unroll
        for (int part = 0; part < 2; ++part) {
            const int c = part * DFF + j;
            const f32x4 z = {0.f, 0.f, 0.f, 0.f};
            const f32x4 pm2 = first ? z : *(const f32x4*)(tail + (size_t)((G - 1) * 2 + 0) * NUP + c), pm1 = first ? z : *(const f32x4*)(tail + (size_t)((G - 1) * 2 + 1) * NUP + c);
            const f32x4 p0 = *(const f32x4*)(head + (size_t)(G * 2 + 0) * NUP + c), p1 = *(const f32x4*)(head + (size_t)(G * 2 + 1) * NUP + c);
            const f32x4 w0 = *(const f32x4*)(cw + c), w1 = *(const f32x4*)(cw + NUP + c), w2 = *(const f32x4*)(cw + 2 * NUP + c), bb = *(const f32x4*)(cb + c);
            hv[part] = rr == 0 ? (w0 * pm2 + w1 * pm1 + w2 * p0 + bb) : (w0 * pm1 + w1 * p0 + w2 * p1 + bb);
        }
        u32x2 w; w.x = cvtpk(gelu_tanh(hv[0][0]) * hv[1][0], gelu_tanh(hv[0][1]) * hv[1][1]); w.y = cvtpk(gelu_tanh(hv[0][2]) * hv[1][2], gelu_tanh(hv[0][3]) * hv[1][3]);
        *(u32x2*)(act + (size_t)(G * 64 + rr) * DFF + j) = w;
    }
}

__device__ __forceinline__ void mlstm_conv(const Args& A, int gt, int ngt) {
    unsigned char* ws = A.ws;
    const bf16_t* src = (const bf16_t*)(ws + WS_R1); bf16_t* dst = (bf16_t*)A.out;
    const float* cw = A.in[15];
    for (int it = gt; it < 128 * 1024; it += ngt) {
        const int c0 = (it & 127) * 8, rb = it >> 7, row0 = rb * 16, t0 = row0 & 4095;
        float w[4][8];
#pragma unroll
        for (int tap = 0; tap < 4; ++tap) { const f32x4 a = *(const f32x4*)(cw + tap * 1024 + c0), b = *(const f32x4*)(cw + tap * 1024 + c0 + 4);
            w[tap][0] = a.x; w[tap][1] = a.y; w[tap][2] = a.z; w[tap][3] = a.w; w[tap][4] = b.x; w[tap][5] = b.y; w[tap][6] = b.z; w[tap][7] = b.w; }
        const float qs = c0 < 512 ? 0.08838834764831845f : 1.0f;
        u32x4 x3 = {0, 0, 0, 0}, x2 = x3, x1 = x3;
        if (t0 > 0) { x3 = *(const u32x4*)(src + (size_t)(row0 - 3) * D + c0); x2 = *(const u32x4*)(src + (size_t)(row0 - 2) * D + c0); x1 = *(const u32x4*)(src + (size_t)(row0 - 1) * D + c0); }
#pragma unroll 4
        for (int r = 0; r < 16; ++r) {
            const u32x4 x0 = *(const u32x4*)(src + (size_t)(row0 + r) * D + c0);
            float y[8];
#pragma unroll
            for (int e = 0; e < 4; ++e) {
                y[2 * e] = w[0][2 * e] * bflo(x3[e]) + w[1][2 * e] * bflo(x2[e]) + w[2][2 * e] * bflo(x1[e]) + w[3][2 * e] * bflo(x0[e]);
                y[2 * e + 1] = w[0][2 * e + 1] * bfhi(x3[e]) + w[1][2 * e + 1] * bfhi(x2[e]) + w[2][2 * e + 1] * bfhi(x1[e]) + w[3][2 * e + 1] * bfhi(x0[e]);
            }
#pragma unroll
            for (int e = 0; e < 8; ++e) y[e] = y[e] * __builtin_amdgcn_rcpf(1.f + __expf(-y[e])) * qs;
            u32x4 o; o.x = cvtpk(y[0], y[1]); o.y = cvtpk(y[2], y[3]); o.z = cvtpk(y[4], y[5]); o.w = cvtpk(y[6], y[7]);
            *(u32x4*)(dst + (size_t)(row0 + r) * D + c0) = o;
            x3 = x2; x2 = x1; x1 = x0;
        }
    }
}
constexpr int ML_PK = 320, ML_PV = 576, ML_PQ = 272;
__device__ __forceinline__ void mlstm_state_unit(const Args& A, ldsp lds, int u) {
    unsigned char* ws = A.ws;
    const int tid = otid(), lane = tid & 63, wid = tid >> 6, n = lane & 31, h = lane >> 5, i16 = lane & 15, q4 = i16 >> 2, p4 = i16 & 3, blk = (lane >> 4) & 1;
    const int bh = u >> 6, c = u & 63, b = bh >> 2, hd = bh & 3, r0 = b * SEQ + c * 64;
    const float* gate = (const float*)(ws + WS_GATE);
    float* chs = (float*)(ws + WS_CH);
    ldsp kt = lds, vt = lds + 64 * ML_PK; LAS float* wk = (LAS float*)(lds + 64 * ML_PK + 64 * ML_PV);
    const bf16_t* kq = (const bf16_t*)A.out + (size_t)r0 * D + 512 + hd * 128;
    const bf16_t* vp = (const bf16_t*)(ws + WS_R1 + 32 * MiB) + (size_t)r0 * D + hd * 256;
    u32x4 kx[2], vx[4];
#pragma unroll
    for (int i = 0; i < 2; ++i) { const int cid = tid + 512 * i, row = cid >> 4, cc = cid & 15; kx[i] = *(const u32x4*)(kq + (size_t)row * D + cc * 8); }
#pragma unroll
    for (int i = 0; i < 4; ++i) { const int cid = tid + 512 * i, row = cid >> 5, cc = cid & 31; vx[i] = *(const u32x4*)(vp + (size_t)row * D + cc * 8); }
    if (tid < 64) {
        const float ic = gate[(size_t)bh * SEQ + c * 64 + tid], fc = gate[(size_t)(16 + bh) * SEQ + c * 64 + tid];
        float bs = fc;
#pragma unroll
        for (int o = 1; o < 64; o <<= 1) { const float x = __shfl_up(bs, o); if (lane >= o) bs += x; }
        const float g = __shfl(bs, 63), a = g - bs + ic;
        float ml = a;
#pragma unroll
        for (int o = 1; o < 64; o <<= 1) ml = fmaxf(ml, __shfl_xor(ml, o));
        wk[tid] = __expf(a - ml);
        if (tid == 0) { chs[u] = g; chs[1024 + u] = ml; }
    }
    __syncthreads();
#pragma unroll
    for (int i = 0; i < 2; ++i) { const int cid = tid + 512 * i, row = cid >> 4, cc = cid & 15; const u32x4 x = kx[i]; const float w = wk[row];
        u32x4 y; y.x = cvtpk(bflo(x.x) * w, bfhi(x.x) * w); y.y = cvtpk(bflo(x.y) * w, bfhi(x.y) * w); y.z = cvtpk(bflo(x.z) * w, bfhi(x.z) * w); y.w = cvtpk(bflo(x.w) * w, bfhi(x.w) * w);
        *(LAS u32x4*)(kt + row * ML_PK + cc * 16) = y; }
#pragma unroll
    for (int i = 0; i < 4; ++i) { const int cid = tid + 512 * i, row = cid >> 5, cc = cid & 31; *(LAS u32x4*)(vt + row * ML_PV + cc * 16) = vx[i]; }
    __syncthreads();
    {
        const int d = tid & 127, qr = tid >> 7; float s = 0.f;
#pragma unroll
        for (int r = 0; r < 16; ++r) s += bf2f(*(const LAS bf16_t*)(kt + (16 * qr + r) * ML_PK + d * 2));
        wk[64 + tid] = s;
    }
    const int ib = wid & 3, vh = wid >> 2;
    f32x16 acc[4];
#pragma unroll
    for (int db = 0; db < 4; ++db)
#pragma unroll
        for (int r = 0; r < 16; ++r) acc[db][r] = 0.f;
#pragma unroll
    for (int st = 0; st < 4; ++st) {
        const bf16x8 af = tr8(kt + (16 * st + 8 * h + q4) * ML_PK + ib * 64 + blk * 32 + 8 * p4, 4 * ML_PK);
#pragma unroll
        for (int db = 0; db < 4; ++db) { const bf16x8 bv = tr8(vt + (16 * st + 8 * h + q4) * ML_PV + (vh * 4 + db) * 64 + blk * 32 + 8 * p4, 4 * ML_PV); acc[db] = MFMA32(af, bv, acc[db]); }
    }
    bf16_t* Sst = (bf16_t*)(ws + WS_R2) + (size_t)u * 128 * 256;
#pragma unroll
    for (int db = 0; db < 4; ++db)
#pragma unroll
        for (int r = 0; r < 16; ++r) Sst[(size_t)(ib * 32 + crow(r, h)) * 256 + (vh * 4 + db) * 32 + n] = f2bf(acc[db][r]);
    __syncthreads();
    if (tid < 128) ((float*)(ws + WS_NST))[(size_t)u * 128 + tid] = (wk[64 + tid] + wk[192 + tid]) + (wk[320 + tid] + wk[448 + tid]);
    __syncthreads();
}
__device__ __forceinline__ void mlstm_scan(const Args& A, int gt, int ngt) {
    unsigned char* ws = A.ws;
    float* chs = (float*)(ws + WS_CH);
    for (int it = gt; it < 16 * 8192 + 2048; it += ngt) {
        const bool isn = it >= 16 * 8192;
        const int bh = isn ? (it - 16 * 8192) >> 7 : it >> 13, e = isn ? (it - 16 * 8192) & 127 : (it & 8191) * 4;
        float m = 0.f; float c0 = 0.f, c1 = 0.f, c2 = 0.f, c3 = 0.f;
        for (int cb = 0; cb < 64; cb += 8) {
            u32x2 xv[8]; float xn[8], gg[8], mm[8];
#pragma unroll
            for (int i = 0; i < 8; ++i) { const int u = bh * 64 + cb + i; gg[i] = chs[u]; mm[i] = chs[1024 + u];
                if (isn) xn[i] = *((const float*)(ws + WS_NST) + (size_t)u * 128 + e); else xv[i] = *(const u32x2*)((const bf16_t*)(ws + WS_R2) + (size_t)u * 32768 + e); }
#pragma unroll
            for (int i = 0; i < 8; ++i) {
                const int u = bh * 64 + cb + i;
                const float g = gg[i], ml = mm[i], mnew = fmaxf(g + m, ml), dec = __expf(g + m - mnew), sc = __expf(ml - mnew);
                if (isn) { *((float*)(ws + WS_NST) + (size_t)u * 128 + e) = c0; c0 = dec * c0 + sc * xn[i]; }
                else { u32x2 y; y.x = cvtpk(c0, c1); y.y = cvtpk(c2, c3); *(u32x2*)((bf16_t*)(ws + WS_R2) + (size_t)u * 32768 + e) = y;
                    c0 = dec * c0 + sc * bflo(xv[i].x); c1 = dec * c1 + sc * bfhi(xv[i].x); c2 = dec * c2 + sc * bflo(xv[i].y); c3 = dec * c3 + sc * bfhi(xv[i].y);
                    if (e == 0) chs[2048 + u] = m; }
                m = mnew;
            }
        }
    }
}
__device__ __forceinline__ void mlstm_out_unit(const Args& A, ldsp lds, int u, bool dummy = false) {
    unsigned char* ws = A.ws;
    const int tid = otid(), lane = tid & 63, wid = tid >> 6, n = lane & 31, h = lane >> 5, i16 = lane & 15, q4 = i16 >> 2, p4 = i16 & 3, blk = (lane >> 4) & 1;
    const int bh = u >> 6, c = u & 63, b = bh >> 2, hd = bh & 3, r0 = b * SEQ + c * 64;
    const float* gate = (const float*)(ws + WS_GATE); const float* chs = (const float*)(ws + WS_CH);
    ldsp qt = lds, kt = lds + 64 * ML_PQ, vt = lds + 2 * 64 * ML_PQ, ct = vt + 64 * ML_PV;
    LAS float* sc = (LAS float*)(ct + 64 * ML_PV);
    LAS float *bt = sc, *ib = sc + 64, *mt = sc + 128, *wi = sc + 192, *qn = sc + 256, *rinv = sc + 320, *nv = sc + 384, *hs = sc + 512;
    const float mc = chs[2048 + u];
    if (tid < 64) {
        const float ic = gate[(size_t)bh * SEQ + c * 64 + tid], fc = gate[(size_t)(16 + bh) * SEQ + c * 64 + tid];
        float bs = fc;
#pragma unroll
        for (int o = 1; o < 64; o <<= 1) { const float x = __shfl_up(bs, o); if (lane >= o) bs += x; }
        const float ibv = ic - bs; float pm = ibv;
#pragma unroll
        for (int o = 1; o < 64; o <<= 1) { const float x = __shfl_up(pm, o); if (lane >= o) pm = fmaxf(pm, x); }
        const float mtv = fmaxf(bs + mc, bs + pm);
        bt[tid] = bs; ib[tid] = ibv; mt[tid] = mtv; wi[tid] = __expf(bs + mc - mtv);
    }
    const bf16_t* qp = (const bf16_t*)A.out + (size_t)r0 * D + hd * 128;
    bf16_t* vp = (bf16_t*)(ws + WS_R1 + 32 * MiB) + (size_t)r0 * D + hd * 256;
    const bf16_t* Cs = (const bf16_t*)(ws + WS_R2) + (size_t)u * 32768;
#pragma unroll
    for (int i = 0; i < 2; ++i) { const int cid = tid + 512 * i, row = cid >> 4, cc = cid & 15;
        *(LAS u32x4*)(qt + row * ML_PQ + cc * 16) = *(const u32x4*)(qp + (size_t)row * D + cc * 8);
        *(LAS u32x4*)(kt + row * ML_PQ + cc * 16) = *(const u32x4*)(qp + (size_t)row * D + 512 + cc * 8); }
    u32x4 c2r[4];
#pragma unroll
    for (int i = 0; i < 4; ++i) { const int cid = tid + 512 * i, row = cid >> 5, cc = cid & 31;
        *(LAS u32x4*)(vt + row * ML_PV + cc * 16) = *(const u32x4*)(vp + (size_t)row * D + cc * 8);
        *(LAS u32x4*)(ct + row * ML_PV + cc * 16) = *(const u32x4*)(Cs + (size_t)row * 256 + cc * 8);
        c2r[i] = *(const u32x4*)(Cs + (size_t)(64 + row) * 256 + cc * 8); }
    if (tid < 128) nv[tid] = ((const float*)(ws + WS_NST))[(size_t)u * 128 + tid];
    const int tb = wid & 1, eq = wid >> 1, t = 32 * tb + n;
    const bf16_t* og = (const bf16_t*)(ws + WS_R1 + 64 * MiB);
    const float* hn = A.in[18];
    bf16_t ogr[16][2]; float hnr[2];
#pragma unroll
    for (int eb = 0; eb < 2; ++eb) { const int col = hd * 256 + eq * 64 + eb * 32 + n; hnr[eb] = hn[col];
#pragma unroll
        for (int r = 0; r < 16; ++r) ogr[r][eb] = og[(size_t)(r0 + 32 * tb + crow(r, h)) * D + col]; }
    __syncthreads();
    {
        const int tq = tid >> 3, part = tid & 7;
        const u32x4 qa = *(const LAS u32x4*)(qt + tq * ML_PQ + part * 32), qb2 = *(const LAS u32x4*)(qt + tq * ML_PQ + part * 32 + 16);
        const LAS f32x4* nv4 = (const LAS f32x4*)(nv + part * 16);
        const f32x4 n0 = nv4[0], n1 = nv4[1], n2 = nv4[2], n3 = nv4[3];
        float s = bflo(qa.x) * n0.x + bfhi(qa.x) * n0.y + bflo(qa.y) * n0.z + bfhi(qa.y) * n0.w + bflo(qa.z) * n1.x + bfhi(qa.z) * n1.y + bflo(qa.w) * n1.z + bfhi(qa.w) * n1.w
                + bflo(qb2.x) * n2.x + bfhi(qb2.x) * n2.y + bflo(qb2.y) * n2.z + bfhi(qb2.y) * n2.w + bflo(qb2.z) * n3.x + bfhi(qb2.z) * n3.y + bflo(qb2.w) * n3.z + bfhi(qb2.w) * n3.w;
        s += __shfl_xor(s, 1); s += __shfl_xor(s, 2); s += __shfl_xor(s, 4);
        if (part == 0) qn[tq] = s;
    }
    f32x16 p[2];
#pragma unroll
    for (int sh = 0; sh < 2; ++sh) {
#pragma unroll
        for (int r = 0; r < 16; ++r) p[sh][r] = 0.f;
#pragma unroll
        for (int st = 0; st < 8; ++st) {
            const bf16x8 a = *(const LAS bf16x8*)(kt + (32 * sh + n) * ML_PQ + (16 * st + 8 * h) * 2), bq = *(const LAS bf16x8*)(qt + t * ML_PQ + (16 * st + 8 * h) * 2);
            p[sh] = MFMA32(a, bq, p[sh]);
        }
    }
    const float btl = bt[t], mtl = mt[t];
    float dsum = 0.f;
#pragma unroll
    for (int sh = 0; sh < 2; ++sh)
#pragma unroll
        for (int g = 0; g < 4; ++g) { const f32x4 iv = *(const LAS f32x4*)(ib + 32 * sh + 8 * g + 4 * h);
#pragma unroll
            for (int e = 0; e < 4; ++e) { const int s = 32 * sh + 8 * g + 4 * h + e; const float w = s <= t ? ex2((btl - mtl + iv[e]) * LOG2E) : 0.f; const float v = p[sh][4 * g + e] * w; p[sh][4 * g + e] = v; dsum += v; } }
    dsum += __shfl_xor(dsum, 32);
    __syncthreads();
    if (eq == 0 && h == 0) { const float den = wi[t] * qn[t] + dsum; rinv[t] = 1.0f / fmaxf(fabsf(den), __expf(-mtl)); }
    f32x16 acc[2];
#pragma unroll
    for (int eb = 0; eb < 2; ++eb)
#pragma unroll
        for (int r = 0; r < 16; ++r) acc[eb][r] = 0.f;
#pragma unroll
    for (int hc = 0; hc < 2; ++hc) {
        if (hc == 1) {
            __syncthreads();
#pragma unroll
            for (int i = 0; i < 4; ++i) { const int cid = tid + 512 * i, row = cid >> 5, cc = cid & 31; *(LAS u32x4*)(ct + row * ML_PV + cc * 16) = c2r[i]; }
            __syncthreads();
        }
#pragma unroll
        for (int st = 0; st < 4; ++st) {
            const bf16x8 a = *(const LAS bf16x8*)(qt + t * ML_PQ + (64 * hc + 16 * st + 8 * h) * 2);
#pragma unroll
            for (int eb = 0; eb < 2; ++eb) { const bf16x8 bv = tr8(ct + (16 * st + 8 * h + q4) * ML_PV + (eq * 2 + eb) * 64 + blk * 32 + 8 * p4, 4 * ML_PV); acc[eb] = MFMA32(a, bv, acc[eb]); }
        }
    }
#pragma unroll
    for (int g = 0; g < 4; ++g) { const f32x4 w4 = *(const LAS f32x4*)(wi + 32 * tb + 8 * g + 4 * h);
#pragma unroll
        for (int eb = 0; eb < 2; ++eb)
#pragma unroll
            for (int e = 0; e < 4; ++e) acc[eb][4 * g + e] *= w4[e]; }
#pragma unroll
    for (int ks = 0; ks < 4; ++ks) {
        const bf16x8 pa = (ks & 2) ? pack8(p[1], ks & 1) : pack8(p[0], ks & 1);
#pragma unroll
        for (int eb = 0; eb < 2; ++eb) { const bf16x8 bv = tr8(vt + (16 * ks + 4 * h + q4) * ML_PV + (eq * 2 + eb) * 64 + blk * 32 + 8 * p4, 8 * ML_PV); acc[eb] = MFMA32(pa, bv, acc[eb]); }
    }
    float ss[16];
#pragma unroll
    for (int g = 0; g < 4; ++g) { const f32x4 r4 = *(const LAS f32x4*)(rinv + 32 * tb + 8 * g + 4 * h);
#pragma unroll
        for (int e = 0; e < 4; ++e) { const int r = 4 * g + e; acc[0][r] *= r4[e]; acc[1][r] *= r4[e]; ss[r] = acc[0][r] * acc[0][r] + acc[1][r] * acc[1][r]; } }
#pragma unroll
    for (int r = 0; r < 16; ++r) {
#pragma unroll
        for (int x = 1; x < 32; x <<= 1) ss[r] += __shfl_xor(ss[r], x);
        if (n == 0) hs[(tb * 4 + eq) * 32 + crow(r, h)] = ss[r]; }
    __syncthreads();
#pragma unroll
    for (int r = 0; r < 16; ++r) {
        const int tr = crow(r, h);
        const float tot = hs[(tb * 4 + 0) * 32 + tr] + hs[(tb * 4 + 1) * 32 + tr] + hs[(tb * 4 + 2) * 32 + tr] + hs[(tb * 4 + 3) * 32 + tr];
        const float rstd = rsqrtf(tot * (1.0f / 256.0f) + EPS);
#pragma unroll
        for (int eb = 0; eb < 2; ++eb) {
            const int col = hd * 256 + eq * 64 + eb * 32 + n; const size_t off = (size_t)(r0 + 32 * tb + tr) * D + col;
            const float ogv = bf2f(ogr[r][eb]);
            (dummy ? (bf16_t*)(ws + 240 * MiB) + (off & 0x7fffff) : (bf16_t*)(ws + WS_R1 + 32 * MiB) + off)[0] = f2bf(acc[eb][r] * rstd * hnr[eb] * __builtin_amdgcn_rcpf(1.f + __expf(-ogv)));
        }
    }
    __syncthreads();
}

#ifndef PR_WQ
#define PR_WQ 0
#endif
#ifndef PR_RC
#define PR_RC 0
#endif
#ifndef PR_MOUT
#define PR_MOUT 0
#endif
#ifndef PR_SYNC
#define PR_SYNC 0
#endif
#ifndef PR_ATT
#define PR_ATT 0
#endif
#ifndef PR_XATT
#define PR_XATT 0
#endif
#ifndef PR_P0
#define PR_P0 0
#endif
#ifndef PR_MST
#define PR_MST 0
#endif
#ifndef PR_INP
#define PR_INP 0
#endif
#ifndef PR_UP
#define PR_UP 0
#endif
#ifndef PR_CONV
#define PR_CONV 0
#endif
__device__ __forceinline__ int static_unit(int nM, int nN, int G, int c, int i) {
    const int nwg = nM * nN; const long L = (long)i * G + c; if (L >= nwg) return -1;
    int wgid = (int)L; { const int q = nwg / 8, r = nwg % 8, xcd = wgid % 8, off = wgid / 8; wgid = (xcd < r ? xcd * (q + 1) : r * (q + 1) + (xcd - r) * q) + off; }
    const int nig = 8 * nN, gid = wgid / nig, fm = gid * 8, gsz = (nM - fm) < 8 ? (nM - fm) : 8;
    return ((fm + ((wgid % nig) % gsz)) << 8) | ((wgid % nig) / gsz);
}
struct OneUnit { int pm, pn;
    __device__ __forceinline__ bool next(int i, pg8::Unit& u) const { if (i) return false; u.pm = pm; u.pn = pn; return true; }
    __device__ __forceinline__ void a_ready(const pg8::Unit&) const {}
    __device__ __forceinline__ void done(const pg8::Unit&) const {} };
#define GEMM_CALL(EPI, g, S, E) pg8::gemm_phase<EPI, pg8::StaticOrder, true, true>(lds, g, S, E)
__global__ void __launch_bounds__(512, 2) mega_fwd(Args A) {
    extern __shared__ __attribute__((aligned(16))) unsigned char lds_raw[];
    ldsp lds = (ldsp)lds_raw;
    cg::grid_group grid = cg::this_grid();
    const int G = gridDim.x, bx = blockIdx.x, vcu = (G % 8 == 0) ? (bx % 8) * (G / 8) + bx / 8 : bx;
    const int ngw = G * 8, ngt = G * 512;
    unsigned char* ws = A.ws;
#define tid otid()
#define lane (otid() & 63)
#define wid __builtin_amdgcn_readfirstlane(otid() >> 6)
#define gw (vcu * 8 + __builtin_amdgcn_readfirstlane(otid() >> 6))
#define gt (bx * 512 + otid())
#define wscr ((LAS float*)(lds + LDS_X) + __builtin_amdgcn_readfirstlane(otid() >> 6) * 64)
    LAS int* bc = (LAS int*)(lds + LDS_X + 4096);
    unsigned* ctr = (unsigned*)(ws + WS_CTL);
    volatile LAS unsigned* xbst = (volatile LAS unsigned*)(lds + LDS_X + 12288);
    if (threadIdx.x < 4) xbst[threadIdx.x] = 0u;
    __syncthreads();
    const XcdBarrier xbar = xcd_barrier_post((unsigned*)(ws + WS_CTL + 4096), xbst);
#define GSYNC() xcd_barrier(xbar)
    bf16_t* xb = (bf16_t*)(ws + WS_XB); float* ssq = (float*)(ws + WS_SSQ);

    for (int rep = 0; rep <= PR_P0; ++rep) {
    for (int it = gw; it < WT_ITEMS; it += ngw) wt_dispatch(A, it, lds + wid * 8448, lane);
    __syncthreads();
    row_pass<0>(A, lds, A.in[0], A.in[6], 1536, A.in[2], gw, ngw, tid, lane);
    }
    for (int m = gw; m < MEMT; m += ngw) {
        const f32x4* xr = (const f32x4*)(A.in[1] + (size_t)m * D) + lane; f32x4 v[4]; float s = 0.f;
#pragma unroll
        for (int j = 0; j < 4; ++j) { v[j] = xr[64 * j]; s += (v[j].x * v[j].x + v[j].y * v[j].y) + (v[j].z * v[j].z + v[j].w * v[j].w); }
        s = wave_sum(s);
        u32x2* o8 = (u32x2*)((bf16_t*)(ws + WS_MEMB) + (size_t)m * D) + lane;
#pragma unroll
        for (int j = 0; j < 4; ++j) { u32x2 w; w.x = cvtpk(v[j].x, v[j].y); w.y = cvtpk(v[j].z, v[j].w); o8[64 * j] = w; }
        if (lane < 16) ((float*)(ws + WS_SSQM))[(size_t)m * 16 + lane] = lane == 0 ? s : 0.f;
    }
    for (int it = gt; it < DFF; it += ngt) {
        const int l = it / (DFF / 2), j = (it % (DFF / 2)) * 2; const float* cw = A.in[24] + (size_t)l * 3 * NUP; const float* cb = A.in[25] + (size_t)l * NUP;
        f32x4* o = (f32x4*)((float*)(ws + WS_CWP) + (size_t)it * 16);
        o[0] = (f32x4){cw[j], cw[j + 1], cw[NUP + j], cw[NUP + j + 1]}; o[1] = (f32x4){cw[2 * NUP + j], cw[2 * NUP + j + 1], cb[j], cb[j + 1]};
        o[2] = (f32x4){cw[DFF + j], cw[DFF + j + 1], cw[NUP + DFF + j], cw[NUP + DFF + j + 1]}; o[3] = (f32x4){cw[2 * NUP + DFF + j], cw[2 * NUP + DFF + j + 1], cb[DFF + j], cb[DFF + j + 1]};
    }
    if (bx == 0 && wid == 0) {
        const float s1 = wave_sum(A.in[8][lane] * A.in[9][lane]), s2 = wave_sum(A.in[10][lane] * A.in[11][lane]);
        if (lane == 0) ((float*)(ws + WS_MISC))[0] = __expf(s1) - __expf(s2) + 0.2f;
    }
    if (G == 0x7fffffff) grid.sync();
    GSYNC();
    for (int rep = 0; rep < PR_SYNC; ++rep) GSYNC();

#pragma clang loop unroll(disable)
    for (int layer = 0; layer < 2; ++layer) {
        if (layer == 0 && bx < 32) seq_cumsum((float*)(ws + WS_GATE) + (size_t)bx * SEQ, LOG2E, (LAS float*)(lds + LDS_X + 8192), tid, lane, wid);
        {
            pg8::Gemm g{xb, (const bf16_t*)(ws + (layer == 0 ? WS_WIN0 : WS_WIN1)), T, 3072, 1024}; pg8::StaticOrder S; S.init(T, 3072, G, bx);
            EpiScaledT E{(bf16_t*)(ws + WS_R1), layer == 0 ? 512 : 1024, layer == 0 ? (size_t)T * 512 : (size_t)T * 1024, layer == 0 ? 512 : 1024, (const LAS float*)(lds + LDS_RSTAB), 0.125f * LOG2E, layer == 0 ? 9u : 0u};
            rstab_fill(lds, S, ssq);
#pragma clang loop unroll(disable)
            for (int rep = 0; rep <= PR_INP; ++rep) { E.ord = 0; GEMM_CALL(EpiScaledT, g, S, E); }
        }
        GSYNC();
        if (layer == 0) {
#pragma clang loop unroll(disable)
            for (int rep = 0; rep <= PR_ATT; ++rep)
            for (;;) {
                const int uq = next_unit(ctr + 8 * rep, bc); if (uq >= 768 + 64) break;
                if (uq < 64) {
                    const int l = uq >> 5;
                    pg8::Gemm g{(const bf16_t*)(ws + WS_MEMB), (const bf16_t*)(ws + WS_WKV) + (size_t)l * 2048 * 1024, MEMT, 2048, 1024}; OneUnit S{(uq >> 3) & 3, uq & 7};
                    EpiScaled E{(bf16_t*)(ws + WS_KV) + (size_t)l * MEMT * 2048, 2048, 0, 2048, (const float*)(ws + WS_SSQM), 1.f, 0u};
                    pg8::gemm_phase<EpiScaled, OneUnit, false, true>(lds, g, S, E);
                    continue;
                }
                const int u = uq - 64;
                const int qb = 15 - u / 48, r = u % 48;
                if (r < 16) diff_unit(A, lds, wscr, r, qb); else fox_unit(A, lds, wscr, r - 16, qb);
            }
            GSYNC();
        } else {
            for (int rep = 0; rep <= PR_RC; ++rep) {
            row_gates_b(A, lds, xb, A.in[14], 2048, A.in[2] + 1024, gw, ngw, tid, lane);
            mlstm_conv(A, gt, ngt);
            }
            GSYNC();
#pragma clang loop unroll(disable)
            for (int rep = 0; rep <= PR_MST; ++rep)
            for (int u = bx; u < 1024; u += G) mlstm_state_unit(A, lds, u);
            GSYNC();
            mlstm_scan(A, gt, ngt);
            GSYNC();
            for (int rep = 0; rep < PR_MOUT; ++rep) for (int u = bx; u < 1024; u += G) mlstm_out_unit(A, lds, u, true);
            for (int u = bx; u < 1024; u += G) mlstm_out_unit(A, lds, u);
            GSYNC();
        }
        {
            pg8::Gemm g{(const bf16_t*)(ws + (layer == 0 ? WS_R2 : WS_R1 + 32 * MiB)), (const bf16_t*)(ws + (layer == 0 ? WS_WOUT0 : WS_WOUT1)), T, 1024, 1024}; pg8::StaticOrder S; S.init(T, 1024, G, bx);
            EpiRes E{layer == 0 ? A.in[0] : (const float*)nullptr, xb, ssq};
            GEMM_CALL(EpiRes, g, S, E);
        }
        GSYNC();
        {
            pg8::Gemm g{xb, (const bf16_t*)(ws + WS_WQ) + (size_t)layer * 1024 * 1024, T, 1024, 1024}; pg8::StaticOrder S; S.init(T, 1024, G, bx);
            EpiScaled E{(bf16_t*)(ws + WS_R1), 1024, 0, 1024, ssq, 0.0625f * LOG2E, 1u};
#pragma clang loop unroll(disable)
            for (int rep = 0; rep <= PR_WQ; ++rep) GEMM_CALL(EpiScaled, g, S, E);
            asm volatile("s_waitcnt vmcnt(0)" ::: "memory"); __syncthreads();
#pragma clang loop unroll(disable)
            for (int i = 0;; ++i) {
                const int uc = static_unit(T / 256, 4, G, bx, i); if (uc < 0) break;
                const int qpm = uc >> 8, qpn = uc & 255;
#pragma clang loop unroll(disable)
                for (int once = 0; once < 1; ++once) xattn_unit2(A, lds, wscr, layer, qpm >> 4, qpn, qpm & 15);
            }
        }
        GSYNC();
        {
            pg8::Gemm g{(const bf16_t*)(ws + WS_R1 + 32 * MiB), (const bf16_t*)(ws + WS_WO) + (size_t)layer * 1024 * 1024, T, 1024, 1024}; pg8::StaticOrder S; S.init(T, 1024, G, bx);
            EpiRes E{nullptr, xb, ssq};
            GEMM_CALL(EpiRes, g, S, E);
        }
        GSYNC();
        {
            pg8::Gemm g{xb, (const bf16_t*)(ws + WS_WUP) + (size_t)layer * NUP * 1024, T, NUP, 1024}; pg8::StaticOrder S; S.init(T, NUP, G, bx);
            EpiUp E{(bf16_t*)(ws + WS_R1), (float*)(ws + WS_R2), (float*)(ws + WS_R2) + (size_t)512 * NUP, ssq, (const float*)(ws + WS_CWP) + (size_t)layer * DFF * 8, (const LAS float*)(lds + LDS_RSTAB), (LAS float*)(lds + LDS_CWPS)};
            rstab_fill(lds, S, ssq);
#pragma clang loop unroll(disable)
            for (int rep = 0; rep <= PR_UP; ++rep) { E.ord = 0; GEMM_CALL(EpiUp, g, S, E); }
        }
        GSYNC();
        ffn_fixup(A, layer, gt, ngt);
        GSYNC();
        {
            pg8::Gemm g{(const bf16_t*)(ws + WS_R1), (const bf16_t*)(ws + WS_WDN) + (size_t)layer * 1024 * DFF, T, 1024, DFF}; pg8::StaticOrder S; S.init(T, 1024, G, bx);
            EpiRes E{nullptr, xb, ssq};
            GEMM_CALL(EpiRes, g, S, E);
        }
        GSYNC();
    }
    {
        u32x4 fnx[2];
        if (gw < T) { fnx[0] = ((const u32x4*)(xb + (size_t)gw * D))[lane]; fnx[1] = ((const u32x4*)(xb + (size_t)gw * D))[64 + lane]; }
        for (int m = gw; m < T; m += ngw) {
            float vv[2][8]; float s = 0.f;
#pragma unroll
            for (int j = 0; j < 2; ++j) { const u32x4 r = fnx[j];
                vv[j][0] = bflo(r.x); vv[j][1] = bfhi(r.x); vv[j][2] = bflo(r.y); vv[j][3] = bfhi(r.y); vv[j][4] = bflo(r.z); vv[j][5] = bfhi(r.z); vv[j][6] = bflo(r.w); vv[j][7] = bfhi(r.w);
#pragma unroll
                for (int e = 0; e < 8; ++e) s += vv[j][e] * vv[j][e]; }
            if (m + ngw < T) { fnx[0] = ((const u32x4*)(xb + (size_t)(m + ngw) * D))[lane]; fnx[1] = ((const u32x4*)(xb + (size_t)(m + ngw) * D))[64 + lane]; }
            const float rstd = rsqrtf(wave_sum(s) * (1.0f / 1024.0f) + EPS);
#pragma unroll
            for (int j = 0; j < 2; ++j) { const f32x4 g0 = *(const f32x4*)(A.in[27] + 512 * j + 8 * lane), g1 = *(const f32x4*)(A.in[27] + 512 * j + 8 * lane + 4);
                f32x4* o = (f32x4*)(A.out + (size_t)m * D + 512 * j + 8 * lane);
                o[0] = (f32x4){vv[j][0], vv[j][1], vv[j][2], vv[j][3]} * rstd * g0; o[1] = (f32x4){vv[j][4], vv[j][5], vv[j][6], vv[j][7]} * rstd * g1; }
        }
    }
#undef tid
#undef lane
#undef wid
#undef gw
#undef gt
#undef wscr
}

extern "C" void kernel_launch(void* const* d_in, const int* in_sizes, int n_in, void* d_out, int out_size, void* d_ws, size_t ws_size, hipStream_t stream) {
    static int grid = 0;
    if (grid == 0) {
        if (n_in != 28 || out_size != T * D || ws_size < WS_END) { fprintf(stderr, "kernel_launch: unexpected problem shape (n_in %d out %d ws %zu)\n", n_in, out_size, ws_size); grid = -1; return; }
        int dev = 0, cus = 0, per_cu = 0;
        if (hipGetDevice(&dev) != hipSuccess || hipDeviceGetAttribute(&cus, hipDeviceAttributeMultiprocessorCount, dev) != hipSuccess) { grid = -1; return; }
        if (hipFuncSetAttribute((const void*)mega_fwd, hipFuncAttributeMaxDynamicSharedMemorySize, LDS_BYTES) != hipSuccess) { fprintf(stderr, "kernel_launch: hipFuncSetAttribute failed\n"); grid = -1; return; }
        if (hipOccupancyMaxActiveBlocksPerMultiprocessor(&per_cu, (const void*)mega_fwd, 512, LDS_BYTES) != hipSuccess || per_cu < 1) { fprintf(stderr, "kernel_launch: occupancy query says %d blocks per CU\n", per_cu); (void)hipGetLastError(); per_cu = 1; }
        grid = cus;
        if (grid < 256) { fprintf(stderr, "kernel_launch: built for >= 256 CUs (got %d)\n", cus); grid = -1; return; }
    }
    if (grid < 0) return;
    (void)hipMemsetAsync((char*)d_ws + WS_CTL, 0, 32768, stream);
    Args a{};
    for (int i = 0; i < 28; ++i) a.in[i] = (const float*)d_in[i];
    a.out = (float*)d_out; a.ws = (unsigned char*)d_ws;
    void* args[] = {&a};
    hipError_t e = hipLaunchCooperativeKernel((const void*)mega_fwd, dim3(grid), dim3(512), args, LDS_BYTES, stream);
    if (e != hipSuccess) fprintf(stderr, "cooperative launch failed: %s (grid %d)\n", hipGetErrorString(e), grid);
}
```
